# Optimizing an MI355X kernel written in HIP

```python
import jax, jax.numpy as jnp
from jax import lax
import numpy as np

D_MODEL = 2048
BATCH = 8
SEQ = 2048
DEPTH = 1

CTX_LEN = 256
GRID_W = 64
D_MIX = D_MODEL
DN_HEADS = 8
DN_HEAD_DIM = D_MIX // 2 // DN_HEADS
DN_WIDTH = DN_HEADS * DN_HEAD_DIM
DN_CHUNK = 64
CONV_K = 5
MLP_WIDTH = D_MIX - DN_WIDTH
MLP_GROUPS = 8
MLP_GROUP_DIM = MLP_WIDTH // MLP_GROUPS
MLP_CHUNK = 128
CHUNK_ROWS = MLP_CHUNK // GRID_W
D_FF = ((8 * D_MODEL // 3 + 127) // 128) * 128
N_MOD = 9
IN_COLS = 4 * DN_WIDTH + 4 * DN_HEADS + 2 * MLP_WIDTH
EPS = 1e-6

kernel_name = "hybrid_deltanet_chunkmlp_macaron_dit"


def _rmsnorm(x, g):
    xf = x.astype(jnp.float32)
    y = xf * lax.rsqrt(jnp.mean(xf * xf, axis=-1, keepdims=True) + EPS)
    return (y * g.astype(jnp.float32)).astype(x.dtype)


def _l2norm(x):
    xf = x.astype(jnp.float32)
    return xf * lax.rsqrt(jnp.sum(xf * xf, axis=-1, keepdims=True) + EPS)


def _modulate(h, shift, scale):
    return h * (1.0 + scale) + shift


def _swiglu(h, w_in, w_out):
    a, b = jnp.split(h @ w_in, 2, axis=-1)
    return (jax.nn.silu(a) * b) @ w_out


def _split_proj(z):
    sizes = [DN_WIDTH] * 4 + [2 * DN_HEADS] * 2 + [MLP_WIDTH] * 2
    idx = [int(i) for i in np.cumsum(sizes)[:-1]]
    q, k, v, gate, a, b, u, vm = jnp.split(z, idx, axis=-1)
    return jnp.concatenate([q, k, v], axis=-1), gate, a, b, u, vm


def _short_conv(x, w):
    C = x.shape[-1]
    y = lax.conv_general_dilated(
        x, w[:, None, :].astype(x.dtype), window_strides=(1,),
        padding=[(CONV_K // 2, CONV_K // 2)],
        dimension_numbers=('NWC', 'WIO', 'NWC'), feature_group_count=C)
    return jax.nn.silu(y)


def _dn_prepare(z_qkv, z_a, z_b, conv_w, a_log, dt_bias):
    B, T, _ = z_qkv.shape
    qkv = _short_conv(z_qkv, conv_w)
    q, k, v = (t.reshape(B, T, DN_HEADS, DN_HEAD_DIM) for t in jnp.split(qkv, 3, axis=-1))
    q = _l2norm(q) * (DN_HEAD_DIM ** -0.5)
    k = _l2norm(k)
    a = z_a.astype(jnp.float32).reshape(B, T, 2, DN_HEADS)
    g = -jnp.exp(a_log.astype(jnp.float32)) * jax.nn.softplus(a + dt_bias.astype(jnp.float32))
    beta = jax.nn.sigmoid(z_b.astype(jnp.float32).reshape(B, T, 2, DN_HEADS))
    return q, k, v, g, beta


def _chunk_gated_delta(q, k, v, g, beta, state0):
    f32 = jnp.float32
    q, k, v, g, beta = (t.astype(f32) for t in (q, k, v, g, beta))
    B, T, H, _ = q.shape
    Dv = v.shape[-1]
    C = DN_CHUNK
    N = T // C

    def chunks(t):
        return jnp.swapaxes(t.reshape((B, N, C, H) + t.shape[3:]), 2, 3)

    qc, kc, vc, gc, bc = map(chunks, (q, k, v, g, beta))
    gc = jnp.cumsum(gc, axis=-1)
    tri = jnp.tril(jnp.ones((C, C), dtype=bool))
    strict = jnp.tril(jnp.ones((C, C), dtype=bool), -1)
    decay = jnp.exp(jnp.where(tri, gc[..., :, None] - gc[..., None, :], -jnp.inf))
    kb = kc * bc[..., None]
    L = jnp.where(strict, jnp.einsum('bnhid,bnhjd->bnhij', kb, kc) * decay, 0.0)
    eye = jnp.eye(C, dtype=f32)
    Tm = lax.linalg.triangular_solve(eye + L, jnp.broadcast_to(eye, L.shape),
                                     left_side=True, lower=True)
    u = jnp.einsum('bnhij,bnhje->bnhie', Tm, vc * bc[..., None])
    w = jnp.einsum('bnhij,bnhjd->bnhid', Tm, kb * jnp.exp(gc)[..., None])
    qk = jnp.where(tri, jnp.einsum('bnhid,bnhjd->bnhij', qc, kc) * decay, 0.0)
    q_dec = qc * jnp.exp(gc)[..., None]
    k_dec = kc * jnp.exp(gc[..., -1:] - gc)[..., None]
    g_last = jnp.exp(gc[..., -1])

    def step(S, xs):
        qk_i, qd_i, w_i, u_i, kd_i, gl_i = xs
        v_new = u_i - jnp.einsum('bhcd,bhde->bhce', w_i, S)
        o_i = jnp.einsum('bhcd,bhde->bhce', qd_i, S) + jnp.einsum('bhij,bhje->bhie', qk_i, v_new)
        S = S * gl_i[..., None, None] + jnp.einsum('bhcd,bhce->bhde', kd_i, v_new)
        return S, o_i

    xs = tuple(jnp.moveaxis(t, 1, 0) for t in (qk, q_dec, w, u, k_dec, g_last))
    S, o = lax.scan(step, state0.astype(f32), xs)
    o = jnp.transpose(o, (1, 0, 3, 2, 4)).reshape(B, T, H, Dv)
    return o, S


def _bidir_delta(dn_ctx, dn_lat):
    qc, kc, vc, gc, bc = dn_ctx
    ql, kl, vl, gl, bl = dn_lat
    B = ql.shape[0]
    o_ctx, o_lat = 0.0, 0.0
    for d in range(2):
        f = (lambda t: jnp.flip(t, axis=1)) if d == 1 else (lambda t: t)
        s0 = jnp.zeros((B, DN_HEADS, DN_HEAD_DIM, DN_HEAD_DIM), jnp.float32)
        oc, s_ctx = _chunk_gated_delta(f(qc), f(kc), f(vc), f(gc[:, :, d]), f(bc[:, :, d]), s0)
        ol, _ = _chunk_gated_delta(f(ql), f(kl), f(vl), f(gl[:, :, d]), f(bl[:, :, d]), s_ctx)
        o_ctx = o_ctx + f(oc)
        o_lat = o_lat + f(ol)
    return o_ctx, o_lat


def _gated_head_norm(o, z_gate, g):
    B, T = o.shape[:2]
    zg = z_gate.astype(jnp.float32).reshape(B, T, DN_HEADS, DN_HEAD_DIM)
    y = _rmsnorm(o, g) * jax.nn.silu(zg)
    return y.reshape(B, T, DN_WIDTH).astype(z_gate.dtype)


def _chunk_mlp(z_u, z_v, n_chunks, w_s, b_s, v_g):
    B, T, _ = z_u.shape
    u = jax.nn.gelu(z_u)
    v = jax.nn.gelu(z_v).reshape(B, n_chunks, MLP_CHUNK, MLP_GROUPS, MLP_GROUP_DIM)
    v = _rmsnorm(v, v_g.reshape(MLP_GROUPS, MLP_GROUP_DIM))
    s = jnp.einsum('gpq,bnqgc->bnpgc', w_s, v) + b_s.T[None, None, :, :, None]
    return u * s.reshape(B, T, MLP_WIDTH)


def setup_inputs(seed: int = 0) -> dict:
    key = jax.random.key(seed)
    ks = jax.random.split(key, 24)
    nrm = jax.random.normal
    f32 = jnp.float32
    dt = jnp.exp(jax.random.uniform(ks[12], (DEPTH, 2, DN_HEADS), f32,
                                    float(np.log(1e-3)), float(np.log(1e-1))))
    return {
        'x': nrm(ks[0], (BATCH, SEQ, D_MODEL), f32),
        'c': nrm(ks[1], (BATCH, D_MODEL), f32),
        'ctx': nrm(ks[2], (BATCH, CTX_LEN, D_MODEL), f32),
        'c_ctx': nrm(ks[3], (D_MODEL,), f32),
        'w_mod': nrm(ks[4], (DEPTH, D_MODEL, N_MOD * D_MODEL), f32) * (0.5 * D_MODEL ** -0.5),
        'b_mod': nrm(ks[5], (DEPTH, N_MOD * D_MODEL), f32) * 0.01,
        'norm_g': 1.0 + 0.1 * nrm(ks[6], (DEPTH, 3, D_MODEL), f32),
        'ffn1_w_in': nrm(ks[7], (DEPTH, D_MODEL, 2 * D_FF), f32) * D_MODEL ** -0.5,
        'ffn1_w_out': nrm(ks[8], (DEPTH, D_FF, D_MODEL), f32) * D_FF ** -0.5,
        'w_in': nrm(ks[9], (DEPTH, D_MODEL, IN_COLS), f32) * D_MODEL ** -0.5,
        'conv_w': nrm(ks[10], (DEPTH, CONV_K, 3 * DN_WIDTH), f32) * CONV_K ** -0.5,
        'a_log': jnp.log(jax.random.uniform(ks[11], (DEPTH, 2, DN_HEADS), f32, 1.0, 16.0)),
        'dt_bias': dt + jnp.log(-jnp.expm1(-dt)),
        'head_norm_g': 1.0 + 0.1 * nrm(ks[13], (DEPTH, DN_HEAD_DIM), f32),
        'spatial_w': nrm(ks[14], (DEPTH, MLP_GROUPS, MLP_CHUNK, MLP_CHUNK), f32) * MLP_CHUNK ** -0.5,
        'spatial_b': 1.0 + 0.1 * nrm(ks[15], (DEPTH, MLP_GROUPS, MLP_CHUNK), f32),
        'mlp_norm_g': 1.0 + 0.1 * nrm(ks[16], (DEPTH, MLP_WIDTH), f32),
        'w_out': nrm(ks[17], (DEPTH, D_MIX, D_MODEL), f32) * D_MIX ** -0.5,
        'ffn2_w_in': nrm(ks[18], (DEPTH, D_MODEL, 2 * D_FF), f32) * D_MODEL ** -0.5,
        'ffn2_w_out': nrm(ks[19], (DEPTH, D_FF, D_MODEL), f32) * D_FF ** -0.5,
        'final_g': 1.0 + 0.1 * nrm(ks[20], (D_MODEL,), f32),
    }


def reference(x, c, ctx, c_ctx, w_mod, b_mod, norm_g, ffn1_w_in, ffn1_w_out, w_in, conv_w,
              a_log, dt_bias, head_norm_g, spatial_w, spatial_b, mlp_norm_g, w_out,
              ffn2_w_in, ffn2_w_out, final_g):
    rows = x.shape[1] // GRID_W
    n_chunks_lat = rows // CHUNK_ROWS
    n_chunks_ctx = ctx.shape[1] // MLP_CHUNK
    for l in range(DEPTH):
        last = l == DEPTH - 1
        m = jnp.split((jax.nn.silu(c) @ w_mod[l] + b_mod[l])[:, None, :], N_MOD, axis=-1)
        mc = jnp.split((jax.nn.silu(c_ctx) @ w_mod[l] + b_mod[l])[None, None, :], N_MOD, axis=-1)

        x = x + 0.5 * m[2] * _swiglu(_modulate(_rmsnorm(x, norm_g[l, 0]), m[0], m[1]),
                                     ffn1_w_in[l], ffn1_w_out[l])
        ctx = ctx + 0.5 * mc[2] * _swiglu(_modulate(_rmsnorm(ctx, norm_g[l, 0]), mc[0], mc[1]),
                                          ffn1_w_in[l], ffn1_w_out[l])

        h_x = _modulate(_rmsnorm(x, norm_g[l, 1]), m[3], m[4])
        h_c = _modulate(_rmsnorm(ctx, norm_g[l, 1]), mc[3], mc[4])
        qkv_x, gate_x, a_x, b_x, u_x, v_x = _split_proj(h_x @ w_in[l])
        qkv_c, gate_c, a_c, b_c, u_c, v_c = _split_proj(h_c @ w_in[l])

        dn_x = _dn_prepare(qkv_x, a_x, b_x, conv_w[l], a_log[l], dt_bias[l])
        dn_c = _dn_prepare(qkv_c, a_c, b_c, conv_w[l], a_log[l], dt_bias[l])
        o_c_dn, o_x_dn = _bidir_delta(dn_c, dn_x)
        o_x_a = _gated_head_norm(o_x_dn, gate_x, head_norm_g[l])
        o_x_b = _chunk_mlp(u_x, v_x, n_chunks_lat, spatial_w[l], spatial_b[l], mlp_norm_g[l])
        x = x + m[5] * (jnp.concatenate([o_x_a, o_x_b], axis=-1) @ w_out[l])

        if not last:
            o_c_a = _gated_head_norm(o_c_dn, gate_c, head_norm_g[l])
            o_c_b = _chunk_mlp(u_c, v_c, n_chunks_ctx, spatial_w[l], spatial_b[l], mlp_norm_g[l])
            ctx = ctx + mc[5] * (jnp.concatenate([o_c_a, o_c_b], axis=-1) @ w_out[l])
            ctx = ctx + 0.5 * mc[8] * _swiglu(_modulate(_rmsnorm(ctx, norm_g[l, 2]), mc[6], mc[7]),
                                              ffn2_w_in[l], ffn2_w_out[l])

        x = x + 0.5 * m[8] * _swiglu(_modulate(_rmsnorm(x, norm_g[l, 2]), m[6], m[7]),
                                     ffn2_w_in[l], ffn2_w_out[l])
    return _rmsnorm(x, final_g)
```

```cpp
#include <hip/hip_runtime.h>
#include <hip/hip_cooperative_groups.h>
#include <cstdio>
namespace cg = cooperative_groups;
namespace pg8 {
#define PG8_LAS __attribute__((address_space(3)))
typedef unsigned short bf16_t;
typedef short bf16x8 __attribute__((ext_vector_type(8)));
typedef float f32x4 __attribute__((ext_vector_type(4)));
typedef unsigned u32x4 __attribute__((ext_vector_type(4)));
constexpr int BM = 256, BK = 64, HALF = 128, HTB = HALF * BK * 2  , STAGE_BYTES = 8 * HTB, NXCD = 8, WGM = 8;

__host__ __device__ __forceinline__ int lds_byte(int r, int c) { const int st = (r >> 4) * 2 + (c >> 5), rr = r & 15, cc = c & 31, ob = rr * 64 + cc * 2; return st * 1024 + (ob ^ (((ob >> 9) & 1) << 5)); }
__host__ __device__ __forceinline__ void stage_rc(int b, int& R, int& C) { const int st = b / 1024, sb = b % 1024, swz = sb ^ (((sb >> 9) & 1) << 5); R = (st >> 1) * 16 + swz / 64; C = (st & 1) * 32 + (swz % 64) / 2; }
__host__ __device__ __forceinline__ int perm32(int rho) { const int n = rho >> 4, i = rho & 15; return 8 * (i >> 2) + 4 * n + (i & 3); }

struct Unit { int pm, pn; };
struct Gemm { const bf16_t* A; const bf16_t* Bt; int M, N, K; };

struct StaticOrder {
    int nM, nN, nwg, G, c;
    __host__ __device__ void init(int M, int N, int G_, int c_) { nM = M / BM; nN = N / BM; nwg = nM * nN; G = G_; c = c_; }
    __host__ __device__ bool next(int i, Unit& u) const {
        const long L = (long)i * G + c; if (L >= nwg) return false;
        int wgid = (int)L; { const int q = nwg / NXCD, r = nwg % NXCD, xcd = wgid % NXCD, off = wgid / NXCD; wgid = (xcd < r ? xcd * (q + 1) : r * (q + 1) + (xcd - r) * q) + off; }
        const int nig = WGM * nN, gid = wgid / nig, fm = gid * WGM, gsz = (nM - fm) < WGM ? (nM - fm) : WGM;
        u.pm = fm + ((wgid % nig) % gsz); u.pn = (wgid % nig) / gsz; return true;
    }
    __device__ __forceinline__ void a_ready(const Unit&) const {}
    __device__ __forceinline__ void done(const Unit&) const {}
};
typedef float f32x2_cv __attribute__((ext_vector_type(2)));
typedef __bf16 bf16x2_cv __attribute__((ext_vector_type(2)));
__device__ __forceinline__ unsigned cvt_pk_bf16(float lo, float hi) { const f32x2_cv v = {lo, hi}; const bf16x2_cv r = __builtin_convertvector(v, bf16x2_cv); return __builtin_bit_cast(unsigned, r); }
template <class Epi, class Sched, bool STAMP = false>
__device__ __forceinline__ void gemm_phase(PG8_LAS unsigned char* lds, const Gemm g, const Sched& S, const Epi& E, unsigned long long* stamps) {
    const int tid = threadIdx.x, wid = __builtin_amdgcn_readfirstlane(tid >> 6), lane = tid & 63, wr = wid >> 2, wc = wid & 3, fr = lane & 15, fq = lane >> 4;
    const int K = g.K, nt = K / BK;
    int ts_lo = 0, ts_hi = 0, nts = 0; const unsigned long long rt_entry = STAMP ? (unsigned long long)wall_clock64() : 0ull;
#define PG8_STAMP() do { if (STAMP && wid == 0 && nts < 64) { const unsigned long long _c = (unsigned long long)clock64(); \
        ts_lo = (lane == nts) ? (int)(unsigned)_c : ts_lo; ts_hi = (lane == nts) ? (int)(unsigned)(_c >> 32) : ts_hi; ++nts; } } while (0)
    PG8_STAMP();
    unsigned voffA[2], voffB[2];
#pragma unroll
    for (int i = 0; i < 2; ++i) { int R, C; stage_rc(tid * 16 + i * 8192, R, C); const int Rb = Epi::PERM ? ((R & ~31) + perm32(R & 31)) : R;
        voffA[i] = (unsigned)(R * K + C) * 2u; voffB[i] = (unsigned)(Rb * K + C) * 2u; }
    const size_t kstep = (size_t)(BK * 2);
    const size_t hstep = (size_t)HALF * K * 2;
    const size_t tstep = 2 * hstep;
    const unsigned ldsw = (unsigned)wid * 1024u;
    const int aoff = lds_byte(wr * 64 + fr, fq * 8), boff = lds_byte(wc * 32 + fr, fq * 8);
#define PG8_SA(b, h) (((b) * 2 + (h)) * HTB)
#define PG8_SB(b, h) ((4 + (b) * 2 + (h)) * HTB)
#define PG8_STAGE(bufoff, gbase, voff) do { _Pragma("unroll") for (int _i = 0; _i < 2; ++_i) \
        __builtin_amdgcn_global_load_lds((const unsigned*)((const char*)(gbase) + (voff)[_i]), (PG8_LAS unsigned*)(lds + (bufoff) + ldsw + _i * 8192), 16, 0, 0); } while (0)
#define PG8_LDA(dst, b, h) do { _Pragma("unroll") for (int m = 0; m < 4; ++m) _Pragma("unroll") for (int k = 0; k < 2; ++k) dst[m][k] = *(const PG8_LAS bf16x8*)(lds + PG8_SA(b, h) + aoff + m * 2048 + k * 1024); } while (0)
#define PG8_LDB(dst, b, h) do { _Pragma("unroll") for (int n = 0; n < 2; ++n) _Pragma("unroll") for (int k = 0; k < 2; ++k) dst[n][k] = *(const PG8_LAS bf16x8*)(lds + PG8_SB(b, h) + boff + n * 2048 + k * 1024); } while (0)
#define PG8_MMA(ai, bj, At, Bt) do { __builtin_amdgcn_s_setprio(1); _Pragma("unroll") for (int m = 0; m < 4; ++m) _Pragma("unroll") for (int n = 0; n < 2; ++n) _Pragma("unroll") for (int k = 0; k < 2; ++k) \
        acc[ai][bj][m][n] = __builtin_amdgcn_mfma_f32_16x16x32_bf16(Bt[n][k], At[m][k], acc[ai][bj][m][n], 0, 0, 0); __builtin_amdgcn_s_setprio(0); } while (0)
#define PG8_WAIT_V(n) asm volatile("s_waitcnt vmcnt(" #n ")" ::: "memory")
#define PG8_WAIT_L(n) asm volatile("s_waitcnt lgkmcnt(" #n ")" ::: "memory")
#define PG8_BAR __builtin_amdgcn_s_barrier()
#define PG8_SCHED __builtin_amdgcn_sched_barrier(0)
    Unit cur, nxt; int ui = 0;
    if (!S.next(0, cur)) return;
    f32x4 acc[2][2][4][2];
#pragma unroll
    for (int a = 0; a < 2; ++a)
#pragma unroll
        for (int b = 0; b < 2; ++b)
#pragma unroll
            for (int m = 0; m < 4; ++m)
#pragma unroll
                for (int n = 0; n < 2; ++n) acc[a][b][m][n] = (f32x4){0.f, 0.f, 0.f, 0.f};
    bf16x8 At[4][2], B0[2][2], B1[2][2];
    const char* cA = (const char*)g.A + (size_t)cur.pm * tstep; const char* cB = (const char*)g.Bt + (size_t)cur.pn * tstep;
    S.a_ready(cur);
    PG8_STAGE(PG8_SB(0, 0), cB, voffB); PG8_STAGE(PG8_SA(0, 0), cA, voffA); PG8_STAGE(PG8_SB(0, 1), cB + hstep, voffB); PG8_STAGE(PG8_SA(0, 1), cA + hstep, voffA);
    if (wr == 1) PG8_BAR;
    PG8_WAIT_V(4); PG8_BAR;
    PG8_STAGE(PG8_SB(1, 0), cB + kstep, voffB); PG8_STAGE(PG8_SA(1, 0), cA + kstep, voffA); PG8_STAGE(PG8_SB(1, 1), cB + hstep + kstep, voffB);
    PG8_WAIT_V(6); PG8_BAR;
    PG8_STAMP();
    for (;;) {
        const bool has_next = S.next(ui + 1, nxt);
        const char* nA = has_next ? (const char*)g.A + (size_t)nxt.pm * tstep : cA; const char* nB = has_next ? (const char*)g.Bt + (size_t)nxt.pn * tstep : cB;
        for (int t = 0; t < nt; t += 2) {
            const bool last = (t == nt - 2);
            const char* a1 = cA + (size_t)(t + 1) * kstep;
            const char* a2 = last ? nA : cA + (size_t)(t + 2) * kstep; const char* b2 = last ? nB : cB + (size_t)(t + 2) * kstep;
            const char* a3 = a2 + kstep; const char* b3 = b2 + kstep;
            if (last && has_next) S.a_ready(nxt);
            PG8_LDB(B0, 0, 0); PG8_SCHED; PG8_LDA(At, 0, 0); PG8_STAGE(PG8_SA(1, 1), a1 + hstep, voffA);
            PG8_WAIT_L(8); PG8_BAR; PG8_WAIT_L(0); PG8_MMA(0, 0, At, B0); PG8_BAR; PG8_SCHED;
            PG8_LDB(B1, 0, 1); PG8_STAGE(PG8_SB(0, 0), b2, voffB);
            PG8_BAR; PG8_WAIT_L(0); PG8_MMA(0, 1, At, B1); PG8_BAR;
            PG8_LDA(At, 0, 1); PG8_STAGE(PG8_SA(0, 0), a2, voffA);
            PG8_BAR; PG8_WAIT_L(0); PG8_MMA(1, 0, At, B0); PG8_BAR; PG8_SCHED;
            PG8_STAGE(PG8_SB(0, 1), b2 + hstep, voffB);
            PG8_WAIT_V(6); PG8_BAR; PG8_MMA(1, 1, At, B1); PG8_BAR;
            PG8_LDB(B0, 1, 0); PG8_SCHED; PG8_LDA(At, 1, 0); PG8_STAGE(PG8_SA(0, 1), a2 + hstep, voffA);
            PG8_WAIT_L(8); PG8_BAR; PG8_WAIT_L(0); PG8_MMA(0, 0, At, B0); PG8_BAR; PG8_SCHED;
            PG8_LDB(B1, 1, 1); PG8_STAGE(PG8_SB(1, 0), b3, voffB);
            PG8_BAR; PG8_WAIT_L(0); PG8_MMA(0, 1, At, B1); PG8_BAR;
            PG8_LDA(At, 1, 1); PG8_STAGE(PG8_SA(1, 0), a3, voffA);
            PG8_BAR; PG8_WAIT_L(0); PG8_MMA(1, 0, At, B0); PG8_BAR; PG8_SCHED;
            PG8_STAGE(PG8_SB(1, 1), b3 + hstep, voffB);
            PG8_WAIT_V(6); PG8_BAR; PG8_MMA(1, 1, At, B1); PG8_BAR;
        }
        PG8_STAMP();
        if constexpr (!Epi::AFTER_DRAIN) { E(acc, cur, wr, wc, fr, fq); S.done(cur); }
        PG8_STAMP();
        if (!has_next) break;
#pragma unroll
        for (int a = 0; a < 2; ++a)
#pragma unroll
            for (int b = 0; b < 2; ++b)
#pragma unroll
                for (int m = 0; m < 4; ++m)
#pragma unroll
                    for (int n = 0; n < 2; ++n) acc[a][b][m][n] = (f32x4){0.f, 0.f, 0.f, 0.f};
        cur = nxt; cA = nA; cB = nB; ++ui;
    }
    PG8_WAIT_V(0);
    if (wr == 0) PG8_BAR;
    PG8_BAR;
    if constexpr (Epi::AFTER_DRAIN) { E.fused(acc, cur, wr, wc, fr, fq, lds, wid, lane); S.done(cur); }
    PG8_STAMP();
    if (STAMP && wid == 0) { stamps[lane] = lane < nts ? (((unsigned long long)(unsigned)ts_hi << 32) | (unsigned)ts_lo) : 0ull;
        if (lane == 62) stamps[62] = rt_entry; if (lane == 63) stamps[63] = (unsigned long long)wall_clock64(); }
#undef PG8_STAMP
#undef PG8_SA
#undef PG8_SB
#undef PG8_STAGE
#undef PG8_LDA
#undef PG8_LDB
#undef PG8_MMA
#undef PG8_WAIT_V
#undef PG8_WAIT_L
#undef PG8_BAR
#undef PG8_SCHED
}
}

using pg8::bf16_t; using pg8::bf16x8; using pg8::f32x4; using pg8::u32x4; using pg8::Unit; using pg8::cvt_pk_bf16;
typedef unsigned u32x2 __attribute__((ext_vector_type(2)));
#define DI __device__ __forceinline__
#define LAS __attribute__((address_space(3)))
#define MFMA16(a, b, c) __builtin_amdgcn_mfma_f32_16x16x32_bf16((a), (b), (c), 0, 0, 0)

constexpr int NT = 512;
constexpr int D = 2048, FF = 5504, NUP = 11008, NIN = 6400;
constexpr int MX = 16384, MC = 2048, MALL = 18432;
constexpr int NMOD = 18432;
constexpr int LDS_BYTES = 147456;

constexpr size_t OFF_WT_FFN_IN = 0;
constexpr size_t OFF_WT_FFN_OUT = OFF_WT_FFN_IN + (size_t)NUP * D * 2;
constexpr size_t OFF_WT_OUT = OFF_WT_FFN_OUT + (size_t)D * FF * 2;
constexpr size_t OFF_MOD = OFF_WT_OUT + (size_t)D * D * 2;
constexpr size_t OFF_AB = OFF_MOD + (size_t)9 * NMOD * 4;
constexpr size_t OFF_SST = OFF_AB + (size_t)MALL * 32 * 4;
constexpr size_t OFF_Z0 = OFF_SST + (size_t)256 * 8192 * 4;
constexpr size_t OFF_G = OFF_Z0;
constexpr size_t OFF_ZQKV = OFF_Z0;
constexpr size_t OFF_ZG = OFF_ZQKV + (size_t)MALL * 3072 * 2;
constexpr size_t OFF_ZU = OFF_ZG + (size_t)MX * 1024 * 2;
constexpr size_t OFF_ZV = OFF_ZU + (size_t)MX * 1024 * 2;
constexpr size_t OFF_H = OFF_ZV + (size_t)MX * 1024 * 2;
constexpr size_t OFF_ODIR = OFF_H;
constexpr size_t OFF_WT_IN = OFF_H + (size_t)MALL * D * 2;
constexpr size_t OFF_CTX1 = OFF_WT_IN + (size_t)NIN * D * 2;
constexpr size_t OFF_PREP = OFF_WT_IN;
constexpr int PREP_STRIDE = 73984;
constexpr int PI_W = 0, PI_U = 16384, PI_QD = 32768, PI_KDT = 49152, PI_QK = 65536, PI_GL = 73728;
constexpr int NSTEP = 36, NROUND = 2, RSTEPS = NSTEP / NROUND;
constexpr int PREP_ITEMS = 8 * 8 * 2 * RSTEPS;
constexpr size_t OFF_O = OFF_PREP + (size_t)PREP_ITEMS * PREP_STRIDE;
constexpr size_t WS_END = OFF_O + (size_t)MX * D * 2;
static_assert(OFF_G + (size_t)MALL * FF * 2 <= OFF_H, "G vs H");
static_assert((size_t)2 * MX * 1024 * 2 <= (size_t)MALL * D * 2, "ODIR fits H");
static_assert(OFF_CTX1 + (size_t)MC * D * 4 <= OFF_O, "ctx1");

struct Params {
    const float *x, *c, *ctx, *c_ctx, *w_mod, *b_mod, *norm_g, *ffn1_w_in, *ffn1_w_out, *w_in, *conv_w, *a_log, *dt_bias, *head_norm_g,
        *spatial_w, *spatial_b, *mlp_norm_g, *w_out, *ffn2_w_in, *ffn2_w_out, *final_g;
    float* out; unsigned char* ws;
};

typedef const __attribute__((address_space(4))) unsigned long long* kargp_t;
DI Params load_params() {
    kargp_t k = (kargp_t)__builtin_amdgcn_kernarg_segment_ptr();
    asm volatile("" : "+s"(k));
    Params q; unsigned long long* dst = (unsigned long long*)&q;
#pragma unroll
    for (int i = 0; i < 23; ++i) dst[i] = k[i];
    return q;
}
DI float bflo(unsigned u) { return __uint_as_float(u << 16); }
DI float bfhi(unsigned u) { return __uint_as_float(u & 0xffff0000u); }
DI float bf2f(bf16_t b) { return __uint_as_float(((unsigned)b) << 16); }
DI unsigned f2bf(float f) { unsigned u = __float_as_uint(f); return (u + 0x7fffu + ((u >> 16) & 1u)) >> 16; }
DI float silu_f(float x) { return x * __builtin_amdgcn_rcpf(1.0f + __expf(-x)); }
DI float gelu_f(float x) { const float u = 1.5957691216057308f * (x + 0.044715f * x * x * x); return x * __builtin_amdgcn_rcpf(1.0f + __expf(-u)); }
DI float wave_sum(float v) {
#pragma unroll
    for (int o = 1; o < 64; o <<= 1) v += __shfl_xor(v, o);
    return v;
}

struct EpiSwiglu {
    static constexpr bool PERM = true, AFTER_DRAIN = false;
    bf16_t* G;
    DI void operator()(const f32x4 (&acc)[2][2][4][2], const Unit& u, int wr, int wc, int fr, int fq) const {
        const int row0 = u.pm * 256 + wr * 64 + fr, col0 = u.pn * 128 + wc * 32 + 8 * fq;
#pragma unroll
        for (int ai = 0; ai < 2; ++ai)
#pragma unroll
            for (int m = 0; m < 4; ++m) {
                const f32x4 a0 = acc[ai][0][m][0], a1 = acc[ai][0][m][1], b0 = acc[ai][1][m][0], b1 = acc[ai][1][m][1];
                u32x4 w;
                w.x = cvt_pk_bf16(silu_f(a0[0]) * b0[0], silu_f(a0[1]) * b0[1]); w.y = cvt_pk_bf16(silu_f(a0[2]) * b0[2], silu_f(a0[3]) * b0[3]);
                w.z = cvt_pk_bf16(silu_f(a1[0]) * b1[0], silu_f(a1[1]) * b1[1]); w.w = cvt_pk_bf16(silu_f(a1[2]) * b1[2], silu_f(a1[3]) * b1[3]);
                *(u32x4*)(G + (size_t)(row0 + ai * 128 + m * 16) * FF + col0) = w;
            }
    }
};
struct EpiResid {
    static constexpr bool PERM = false, AFTER_DRAIN = false;
    const float* srcx; const float* srcc; float* dstx; float* dstc; const float* mod; int gate_idx; float coef;
    DI void operator()(const f32x4 (&acc)[2][2][4][2], const Unit& u, int wr, int wc, int fr, int fq) const {
        const bool isc = u.pm >= 64; const int mb = isc ? 8 : (u.pm >> 3);
        const int row0 = (isc ? (u.pm - 64) : u.pm) * 256 + wr * 64 + fr, col0 = u.pn * 256 + wc * 32 + 4 * fq;
        const float* src = isc ? srcc : srcx; float* dst = isc ? dstc : dstx;
        const float* gate = mod + (size_t)mb * NMOD + gate_idx * D + col0;
        f32x4 gv[2][2];
#pragma unroll
        for (int bj = 0; bj < 2; ++bj)
#pragma unroll
            for (int n = 0; n < 2; ++n) gv[bj][n] = *(const f32x4*)(gate + bj * 128 + n * 16) * coef;
#pragma unroll
        for (int ai = 0; ai < 2; ++ai)
#pragma unroll
            for (int m = 0; m < 4; ++m) {
                const size_t off = (size_t)(row0 + ai * 128 + m * 16) * D + col0;
#pragma unroll
                for (int bj = 0; bj < 2; ++bj)
#pragma unroll
                    for (int n = 0; n < 2; ++n) {
                        const f32x4 s = *(const f32x4*)(src + off + bj * 128 + n * 16);
                        *(f32x4*)(dst + off + bj * 128 + n * 16) = s + gv[bj][n] * acc[ai][bj][m][n];
                    }
                asm volatile("" ::: "memory");
            }
    }
};
struct EpiInproj {
    static constexpr bool PERM = true, AFTER_DRAIN = false;
    unsigned char* ws;
    DI void operator()(const f32x4 (&acc)[2][2][4][2], const Unit& u, int wr, int wc, int fr, int fq) const {
        const int row0 = u.pm * 256 + wr * 64 + fr;
        if (u.pn == 24) {
            if (wc == 0) {
                float* AB = (float*)(ws + OFF_AB);
#pragma unroll
                for (int ai = 0; ai < 2; ++ai)
#pragma unroll
                    for (int m = 0; m < 4; ++m) {
                        float* rp = AB + (size_t)(row0 + ai * 128 + m * 16) * 32 + 8 * fq;
                        *(f32x4*)rp = acc[ai][0][m][0]; *(f32x4*)(rp + 4) = acc[ai][0][m][1];
                    }
            }
            return;
        }
        if (u.pn >= 12 && u.pm >= 64) return;
        int act, ld, colt; bf16_t* base;
        if (u.pn < 12) { act = 0; ld = 3072; colt = u.pn * 256; base = (bf16_t*)(ws + OFF_ZQKV); }
        else if (u.pn < 16) { act = 1; ld = 1024; colt = (u.pn - 12) * 256; base = (bf16_t*)(ws + OFF_ZG); }
        else if (u.pn < 20) { act = 2; ld = 1024; colt = (u.pn - 16) * 256; base = (bf16_t*)(ws + OFF_ZU); }
        else { act = 2; ld = 1024; colt = (u.pn - 20) * 256; base = (bf16_t*)(ws + OFF_ZV); }
        const int col0 = colt + wc * 32 + 8 * fq;
#pragma unroll
        for (int ai = 0; ai < 2; ++ai)
#pragma unroll
            for (int m = 0; m < 4; ++m) {
                bf16_t* rowp = base + (size_t)(row0 + ai * 128 + m * 16) * ld + col0;
#pragma unroll
                for (int bj = 0; bj < 2; ++bj) {
                    f32x4 v0 = acc[ai][bj][m][0], v1 = acc[ai][bj][m][1];
                    if (act == 1) {
#pragma unroll
                        for (int j = 0; j < 4; ++j) { v0[j] = silu_f(v0[j]); v1[j] = silu_f(v1[j]); }
                    } else if (act == 2) {
#pragma unroll
                        for (int j = 0; j < 4; ++j) { v0[j] = gelu_f(v0[j]); v1[j] = gelu_f(v1[j]); }
                    }
                    u32x4 w; w.x = cvt_pk_bf16(v0[0], v0[1]); w.y = cvt_pk_bf16(v0[2], v0[3]); w.z = cvt_pk_bf16(v1[0], v1[1]); w.w = cvt_pk_bf16(v1[2], v1[3]);
                    *(u32x4*)(rowp + bj * 128) = w;
                }
            }
    }
};

DI int src_col(int mode, int n) {
    if (mode == 1) { const int pn = n >> 8, j = n & 255; return j < 128 ? pn * 128 + j : FF + pn * 128 + (j - 128); }
    if (mode == 2) { if (n < 4096) return n; if (n < 6144) return n + 32; if (n < 6176) return n - 6144 + 4096; return -1; }
    return n;
}
DI void transpose_item(const float* W, int K, int N, int Ndst, int mode, bf16_t* WT, LAS float* scr, int item, int lane) {
    const int nblk = Ndst / 32, kb = item / nblk, nb = item % nblk, k0 = 64 * kb, n0 = 32 * nb;
    const int s0 = src_col(mode, n0);
    if (s0 >= 0) {
#pragma unroll 8
        for (int i = 0; i < 32; ++i) { const int kk = 2 * i + (lane >> 5); scr[kk * 33 + (lane & 31)] = W[(size_t)(k0 + kk) * N + s0 + (lane & 31)]; }
    } else {
#pragma unroll 8
        for (int i = 0; i < 32; ++i) { const int kk = 2 * i + (lane >> 5); scr[kk * 33 + (lane & 31)] = 0.f; }
    }
    asm volatile("s_waitcnt vmcnt(0) lgkmcnt(0)" ::: "memory");
    const int c = lane & 7;
#pragma unroll
    for (int j = 0; j < 4; ++j) {
        const int n = (lane >> 3) + 8 * j; const LAS float* s = scr + (8 * c) * 33 + n;
        u32x4 o; o.x = cvt_pk_bf16(s[0 * 33], s[1 * 33]); o.y = cvt_pk_bf16(s[2 * 33], s[3 * 33]); o.z = cvt_pk_bf16(s[4 * 33], s[5 * 33]); o.w = cvt_pk_bf16(s[6 * 33], s[7 * 33]);
        *(u32x4*)(WT + (size_t)(n0 + n) * K + k0 + 8 * c) = o;
    }
    asm volatile("s_waitcnt lgkmcnt(0)" ::: "memory");
}
DI void convert_weights(const float* W, int K, int N, int Ndst, int mode, bf16_t* WT, LAS unsigned char* L, int gw, int NGW, int wid, int lane) {
    LAS float* scr = (LAS float*)(L + wid * 8704);
    const int nitems = (K / 64) * (Ndst / 32);
    for (int it = gw; it < nitems; it += NGW) transpose_item(W, K, N, Ndst, mode, WT, scr, it, lane);
}

DI void mod_gemv(const Params& p, LAS unsigned char* L, int bid, int G) {
    const int tid = threadIdx.x, lane = tid & 63, wid = tid >> 6;
    LAS float* sc = (LAS float*)L;
    LAS float* red = (LAS float*)(L + 9 * 2048 * 4);
    for (int i = tid; i < 9 * 2048; i += NT) { const int r = i >> 11, k = i & 2047; const float v = r < 8 ? p.c[r * 2048 + k] : p.c_ctx[k]; sc[i] = v / (1.0f + expf(-v)); }
    __syncthreads();
    float* MOD = (float*)(p.ws + OFF_MOD);
    const int cgi = lane & 15, ksub = lane >> 4, ks = wid * 4 + ksub;
    for (int item = bid; item < NMOD / 64; item += G) {
        const int n0 = item * 64;
        f32x4 acc[9];
#pragma unroll
        for (int r = 0; r < 9; ++r) acc[r] = (f32x4){0.f, 0.f, 0.f, 0.f};
        const float* wp = p.w_mod + (size_t)(ks * 64) * NMOD + n0 + cgi * 4;
#pragma unroll 4
        for (int kk = 0; kk < 64; ++kk) {
            const f32x4 wv = *(const f32x4*)(wp + (size_t)kk * NMOD);
#pragma unroll
            for (int r = 0; r < 9; ++r) acc[r] += wv * sc[r * 2048 + ks * 64 + kk];
        }
#pragma unroll
        for (int r = 0; r < 9; ++r)
#pragma unroll
            for (int j = 0; j < 4; ++j) { float v = acc[r][j]; v += __shfl_xor(v, 16); v += __shfl_xor(v, 32); acc[r][j] = v; }
        if (ksub == 0) {
#pragma unroll
            for (int r = 0; r < 9; ++r) *(LAS f32x4*)(red + (wid * 9 + r) * 64 + cgi * 4) = acc[r];
        }
        __syncthreads();
        for (int i = tid; i < 9 * 64; i += NT) {
            const int r = i >> 6, col = i & 63; float s = p.b_mod[n0 + col];
#pragma unroll
            for (int w = 0; w < 8; ++w) s += red[(w * 9 + r) * 64 + col];
            MOD[(size_t)r * NMOD + n0 + col] = s;
        }
        __syncthreads();
    }
}

DI void norm_mod_phase(const float* srcx, const float* srcc, int nrows, const float* g, const float* mod, int shift_idx, bf16_t* H, int gw, int NGW, int lane) {
    for (int r = gw; r < nrows; r += NGW) {
        const float* src = r < MX ? srcx + (size_t)r * D : srcc + (size_t)(r - MX) * D;
        const int mb = r < MX ? (r >> 11) : 8;
        const f32x4* xr = (const f32x4*)src + lane;
        f32x4 v[8]; float ss = 0.f;
#pragma unroll
        for (int j = 0; j < 8; ++j) { v[j] = xr[64 * j]; ss += (v[j].x * v[j].x + v[j].y * v[j].y) + (v[j].z * v[j].z + v[j].w * v[j].w); }
        const float rstd = rsqrtf(wave_sum(ss) * (1.0f / D) + 1e-6f);
        const float* sh = mod + (size_t)mb * NMOD + shift_idx * D; const float* scl = sh + D;
        u32x2* o8 = (u32x2*)(H + (size_t)r * D) + lane;
#pragma unroll
        for (int j = 0; j < 8; ++j) {
            const int c = (lane + 64 * j) * 4;
            const f32x4 gg = *(const f32x4*)(g + c), s1 = *(const f32x4*)(scl + c), s0 = *(const f32x4*)(sh + c);
            const f32x4 y = (v[j] * rstd) * gg * (s1 + 1.0f) + s0;
            u32x2 w; w.x = cvt_pk_bf16(y.x, y.y); w.y = cvt_pk_bf16(y.z, y.w); o8[64 * j] = w;
        }
    }
}
DI void final_norm_phase(float* xo, const float* g, int gw, int NGW, int lane) {
    for (int r = gw; r < MX; r += NGW) {
        f32x4* xr = (f32x4*)(xo + (size_t)r * D) + lane;
        f32x4 v[8]; float ss = 0.f;
#pragma unroll
        for (int j = 0; j < 8; ++j) { v[j] = xr[64 * j]; ss += (v[j].x * v[j].x + v[j].y * v[j].y) + (v[j].z * v[j].z + v[j].w * v[j].w); }
        const float rstd = rsqrtf(wave_sum(ss) * (1.0f / D) + 1e-6f);
#pragma unroll
        for (int j = 0; j < 8; ++j) { const int c = (lane + 64 * j) * 4; xr[64 * j] = (v[j] * rstd) * *(const f32x4*)(g + c); }
    }
}

constexpr int PL_QN = 0, PL_KN = 17408, PL_KT = 34816, PL_VT = 53248, PL_KK = 71680, PL_QK = 88320, PL_LC = 104960, PL_TB = 121344, PL_TBG = 130560, PL_VEC = 139776;
static_assert(PL_VEC + 1024 <= LDS_BYTES, "prep lds");

DI void dn_prep_item(const Params& p, LAS unsigned char* L, int b, int h, int d, int s, int slot) {
    int tid_ = threadIdx.x; asm volatile("" : "+v"(tid_));
    const int tid = tid_, lane = tid & 63, wid = tid >> 6, fr = lane & 15, fq = lane >> 4;
    LAS bf16_t* Qn = (LAS bf16_t*)(L + PL_QN); LAS bf16_t* Kn = (LAS bf16_t*)(L + PL_KN);
    LAS bf16_t* KT = (LAS bf16_t*)(L + PL_KT); LAS bf16_t* VT = (LAS bf16_t*)(L + PL_VT);
    LAS float* KKf = (LAS float*)(L + PL_KK); LAS float* QKf = (LAS float*)(L + PL_QK); LAS float* Lc = (LAS float*)(L + PL_LC);
    LAS bf16_t* TB = (LAS bf16_t*)(L + PL_TB); LAS bf16_t* TBG = (LAS bf16_t*)(L + PL_TBG);
    LAS float* vgc = (LAS float*)(L + PL_VEC); LAS float* vbeta = vgc + 64;
    int base_row, seq_lo, seq_hi;
    if (s < 4) { const int cc = d ? 3 - s : s; seq_lo = MX + b * 256; seq_hi = seq_lo + 256; base_row = seq_lo + cc * 64; }
    else { const int lc = d ? 31 - (s - 4) : (s - 4); seq_lo = b * 2048; seq_hi = seq_lo + 2048; base_row = seq_lo + lc * 64; }
    unsigned char* item = p.ws + OFF_PREP + (size_t)slot * PREP_STRIDE;

    {
        const int t = tid >> 3, sg = tid & 7, row = base_row + t;
        const bf16_t* Z = (const bf16_t*)(p.ws + OFF_ZQKV);
#pragma unroll
        for (int seg = 0; seg < 3; ++seg) {
            const int ch0 = seg * 1024 + h * 128 + sg * 16;
            float y[16];
#pragma unroll
            for (int hf = 0; hf < 2; ++hf) {
                float a[8];
#pragma unroll
                for (int i = 0; i < 8; ++i) a[i] = 0.f;
#pragma unroll
                for (int j = 0; j < 5; ++j) {
                    const int rr = row + j - 2;
                    if (rr >= seq_lo && rr < seq_hi) {
                        const u32x4 zz = *(const u32x4*)(Z + (size_t)rr * 3072 + ch0 + hf * 8);
                        const float* cw = p.conv_w + j * 3072 + ch0 + hf * 8;
                        const f32x4 w0 = *(const f32x4*)cw, w1 = *(const f32x4*)(cw + 4);
                        a[0] += w0.x * bflo(zz.x); a[1] += w0.y * bfhi(zz.x); a[2] += w0.z * bflo(zz.y); a[3] += w0.w * bfhi(zz.y);
                        a[4] += w1.x * bflo(zz.z); a[5] += w1.y * bfhi(zz.z); a[6] += w1.z * bflo(zz.w); a[7] += w1.w * bfhi(zz.w);
                    }
                }
#pragma unroll
                for (int i = 0; i < 8; ++i) y[hf * 8 + i] = a[i] / (1.0f + __expf(-a[i]));
            }
            if (seg < 2) {
                float ss = 0.f;
#pragma unroll
                for (int i = 0; i < 16; ++i) ss += y[i] * y[i];
                ss += __shfl_xor(ss, 1); ss += __shfl_xor(ss, 2); ss += __shfl_xor(ss, 4);
                const float sc = rsqrtf(ss + 1e-6f) * (seg == 0 ? 0.08838834764831845f : 1.0f);
#pragma unroll
                for (int i = 0; i < 16; ++i) y[i] *= sc;
            }
            if (seg < 2) {
                u32x4 w0, w1;
                w0.x = cvt_pk_bf16(y[0], y[1]); w0.y = cvt_pk_bf16(y[2], y[3]); w0.z = cvt_pk_bf16(y[4], y[5]); w0.w = cvt_pk_bf16(y[6], y[7]);
                w1.x = cvt_pk_bf16(y[8], y[9]); w1.y = cvt_pk_bf16(y[10], y[11]); w1.z = cvt_pk_bf16(y[12], y[13]); w1.w = cvt_pk_bf16(y[14], y[15]);
                LAS bf16_t* dst = (seg == 0 ? Qn : Kn) + t * 136 + sg * 16;
                *(LAS u32x4*)dst = w0; *(LAS u32x4*)(dst + 8) = w1;
            }
            if (seg >= 1) {
                LAS bf16_t* dstT = (seg == 1 ? KT : VT) + (sg * 16) * 72 + t;
#pragma unroll
                for (int i = 0; i < 16; ++i) dstT[i * 72] = (bf16_t)f2bf(y[i]);
            }
        }
    }
    if (wid == 0) {
        const int tok = d ? 63 - lane : lane;
        const float* AB = (const float*)(p.ws + OFF_AB) + (size_t)(base_row + tok) * 32;
        const float a = AB[d * 8 + h], bb = AB[16 + d * 8 + h];
        const float xx = a + p.dt_bias[d * 8 + h];
        const float sp = xx > 20.f ? xx : log1pf(expf(xx));
        float gcv = -expf(p.a_log[d * 8 + h]) * sp;
#pragma unroll
        for (int o = 1; o < 64; o <<= 1) { const float t = __shfl_up(gcv, o); if (lane >= o) gcv += t; }
        vgc[lane] = gcv; vbeta[lane] = 1.0f / (1.0f + expf(-bb));
    }
    __syncthreads();
    {
        const LAS bf16_t* Am = (wid >> 2) ? Qn : Kn; LAS float* Mo = (wid >> 2) ? QKf : KKf; const int ti = wid & 3;
        bf16x8 af[4];
#pragma unroll
        for (int k = 0; k < 4; ++k) af[k] = *(const LAS bf16x8*)(Am + (ti * 16 + fr) * 136 + k * 32 + fq * 8);
#pragma unroll
        for (int tj = 0; tj < 4; ++tj) {
            f32x4 acc = (f32x4){0.f, 0.f, 0.f, 0.f};
#pragma unroll
            for (int k = 0; k < 4; ++k) acc = MFMA16(af[k], *(const LAS bf16x8*)(Kn + (tj * 16 + fr) * 136 + k * 32 + fq * 8), acc);
#pragma unroll
            for (int j = 0; j < 4; ++j) Mo[(ti * 16 + fq * 4 + j) * 65 + tj * 16 + fr] = acc[j];
        }
    }
    __syncthreads();
#pragma unroll
    for (int e = 0; e < 8; ++e) {
        const int idx = tid + NT * e, j = idx >> 6, i = idx & 63;
        const int ti = d ? 63 - i : i, tj = d ? 63 - j : j;
        Lc[idx] = (i > j) ? vbeta[i] * KKf[ti * 65 + tj] * __expf(vgc[i] - vgc[j]) : 0.f;
    }
    __syncthreads();
    if (wid == 0) {
        unsigned lcb = (unsigned)(size_t)Lc; asm volatile("" : "+v"(lcb));
        const LAS float* Lcv = (const LAS float*)lcb;
        float x[64];
#pragma unroll
        for (int i = 0; i < 64; ++i) x[i] = (i == lane) ? 1.f : 0.f;
#pragma unroll
        for (int j = 0; j < 63; ++j) {
            const float xj = x[j];
            asm volatile("" ::: "memory");
#pragma unroll
            for (int i4 = ((j + 1) & ~3); i4 < 64; i4 += 4) {
                const f32x4 l = *(const LAS f32x4*)(Lcv + j * 64 + i4);
                x[i4] -= l.x * xj; x[i4 + 1] -= l.y * xj; x[i4 + 2] -= l.z * xj; x[i4 + 3] -= l.w * xj;
            }
        }
        const float bc = vbeta[lane], bg = bc * __expf(vgc[lane]); const int tc = d ? 63 - lane : lane;
#pragma unroll
        for (int i = 0; i < 64; ++i) { TB[i * 72 + tc] = (bf16_t)f2bf(x[i] * bc); TBG[i * 72 + tc] = (bf16_t)f2bf(x[i] * bg); }
    } else {
        const int t2 = tid - 64; const float gl = vgc[63];
        if (s >= 4) {
            unsigned* oqk = (unsigned*)(item + PI_QK);
            for (int idx = t2; idx < 2048; idx += NT - 64) {
                const int i = idx >> 5, j0 = (idx & 31) * 2, ti = d ? 63 - i : i;
                const int tj0 = d ? 63 - j0 : j0, tj1 = d ? 62 - j0 : j0 + 1;
                const float v0 = (i >= j0) ? QKf[ti * 65 + tj0] * __expf(vgc[i] - vgc[j0]) : 0.f;
                const float v1 = (i >= j0 + 1) ? QKf[ti * 65 + tj1] * __expf(vgc[i] - vgc[j0 + 1]) : 0.f;
                oqk[idx] = cvt_pk_bf16(v0, v1);
            }
            u32x4* oqd = (u32x4*)(item + PI_QD);
            for (int idx = t2; idx < 1024; idx += NT - 64) {
                const int i = idx >> 4, c8 = idx & 15, ti = d ? 63 - i : i; const float eg = __expf(vgc[i]);
                const u32x4 q = *(const LAS u32x4*)(Qn + ti * 136 + c8 * 8); u32x4 o;
                o.x = cvt_pk_bf16(bflo(q.x) * eg, bfhi(q.x) * eg); o.y = cvt_pk_bf16(bflo(q.y) * eg, bfhi(q.y) * eg);
                o.z = cvt_pk_bf16(bflo(q.z) * eg, bfhi(q.z) * eg); o.w = cvt_pk_bf16(bflo(q.w) * eg, bfhi(q.w) * eg);
                oqd[idx] = o;
            }
        }
        u32x4* okd = (u32x4*)(item + PI_KDT);
        for (int idx = t2; idx < 1024; idx += NT - 64) {
            const int dk = idx >> 3, j8 = idx & 7, tmin = d ? 56 - j8 * 8 : j8 * 8;
            const u32x4 kq = *(const LAS u32x4*)(KT + dk * 72 + tmin);
            float e[8] = {bflo(kq.x), bfhi(kq.x), bflo(kq.y), bfhi(kq.y), bflo(kq.z), bfhi(kq.z), bflo(kq.w), bfhi(kq.w)};
            float r[8];
#pragma unroll
            for (int jj = 0; jj < 8; ++jj) r[jj] = (d ? e[7 - jj] : e[jj]) * __expf(gl - vgc[j8 * 8 + jj]);
            u32x4 o; o.x = cvt_pk_bf16(r[0], r[1]); o.y = cvt_pk_bf16(r[2], r[3]); o.z = cvt_pk_bf16(r[4], r[5]); o.w = cvt_pk_bf16(r[6], r[7]);
            okd[idx] = o;
        }
        if (t2 == 0) *(float*)(item + PI_GL) = __expf(gl);
    }
    __syncthreads();
    {
        const int mat = wid >> 2, ti = wid & 3;
        const LAS bf16_t* Am = mat ? TBG : TB; const LAS bf16_t* Bm = mat ? KT : VT;
        bf16_t* og = (bf16_t*)(item + (mat ? PI_W : PI_U)); const float sgn = mat ? -1.f : 1.f;
        const bf16x8 a0 = *(const LAS bf16x8*)(Am + (ti * 16 + fr) * 72 + fq * 8), a1 = *(const LAS bf16x8*)(Am + (ti * 16 + fr) * 72 + 32 + fq * 8);
#pragma unroll
        for (int tn = 0; tn < 8; ++tn) {
            f32x4 acc = (f32x4){0.f, 0.f, 0.f, 0.f};
            acc = MFMA16(a0, *(const LAS bf16x8*)(Bm + (tn * 16 + fr) * 72 + fq * 8), acc);
            acc = MFMA16(a1, *(const LAS bf16x8*)(Bm + (tn * 16 + fr) * 72 + 32 + fq * 8), acc);
#pragma unroll
            for (int j = 0; j < 4; ++j) og[(ti * 16 + fq * 4 + j) * 128 + tn * 16 + fr] = (bf16_t)f2bf(acc[j] * sgn);
        }
    }
    __syncthreads();
}

DI void chunk_mlp_item(const Params& p, LAS unsigned char* L, int b, int n, int g) {
    int tid_ = threadIdx.x; asm volatile("" : "+v"(tid_));
    const int tid = tid_, lane = tid & 63, wid = tid >> 6, fr = lane & 15, fq = lane >> 4;
    LAS bf16_t* SW = (LAS bf16_t*)L; LAS bf16_t* VNT = (LAS bf16_t*)(L + 34816);
    const int row0 = b * 2048 + n * 128;
    {
        const int pr = tid >> 2, part = tid & 3;
        const float* sw = p.spatial_w + ((size_t)g * 128 + pr) * 128 + part * 32;
#pragma unroll
        for (int i = 0; i < 4; ++i) {
            const f32x4 a = *(const f32x4*)(sw + i * 8), c = *(const f32x4*)(sw + i * 8 + 4);
            u32x4 w; w.x = cvt_pk_bf16(a.x, a.y); w.y = cvt_pk_bf16(a.z, a.w); w.z = cvt_pk_bf16(c.x, c.y); w.w = cvt_pk_bf16(c.z, c.w);
            *(LAS u32x4*)(SW + pr * 136 + part * 32 + i * 8) = w;
        }
        const bf16_t* zv = (const bf16_t*)(p.ws + OFF_ZV) + (size_t)(row0 + pr) * 1024 + g * 128 + part * 32;
        float v[32]; float ss = 0.f;
#pragma unroll
        for (int i = 0; i < 4; ++i) {
            const u32x4 q = *(const u32x4*)(zv + i * 8);
            v[i * 8 + 0] = bflo(q.x); v[i * 8 + 1] = bfhi(q.x); v[i * 8 + 2] = bflo(q.y); v[i * 8 + 3] = bfhi(q.y);
            v[i * 8 + 4] = bflo(q.z); v[i * 8 + 5] = bfhi(q.z); v[i * 8 + 6] = bflo(q.w); v[i * 8 + 7] = bfhi(q.w);
        }
#pragma unroll
        for (int i = 0; i < 32; ++i) ss += v[i] * v[i];
        ss += __shfl_xor(ss, 1); ss += __shfl_xor(ss, 2);
        const float rstd = rsqrtf(ss * (1.0f / 128.0f) + 1e-6f);
        const float* vg = p.mlp_norm_g + g * 128 + part * 32;
#pragma unroll
        for (int i = 0; i < 32; ++i) VNT[(part * 32 + i) * 136 + pr] = (bf16_t)f2bf(v[i] * rstd * vg[i]);
    }
    __syncthreads();
    f32x4 acc[8];
#pragma unroll
    for (int ci = 0; ci < 8; ++ci) acc[ci] = (f32x4){0.f, 0.f, 0.f, 0.f};
#pragma unroll
    for (int k = 0; k < 4; ++k) {
        const bf16x8 a = *(const LAS bf16x8*)(SW + (wid * 16 + fr) * 136 + k * 32 + fq * 8);
#pragma unroll
        for (int ci = 0; ci < 8; ++ci) acc[ci] = MFMA16(a, *(const LAS bf16x8*)(VNT + (ci * 16 + fr) * 136 + k * 32 + fq * 8), acc[ci]);
    }
    const bf16_t* ZU = (const bf16_t*)(p.ws + OFF_ZU); bf16_t* O = (bf16_t*)(p.ws + OFF_O);
#pragma unroll
    for (int j = 0; j < 4; ++j) {
        const int pp = wid * 16 + fq * 4 + j; const float bs = p.spatial_b[g * 128 + pp]; const size_t row = row0 + pp;
#pragma unroll
        for (int ci = 0; ci < 8; ++ci) {
            const int cc = g * 128 + ci * 16 + fr;
            O[row * D + 1024 + cc] = (bf16_t)f2bf(bf2f(ZU[row * 1024 + cc]) * (acc[ci][j] + bs));
        }
    }
    __syncthreads();
}

constexpr int SL_W = 0, SL_QD = 17408, SL_KDT = 34816, SL_QK = 53248, SL_ST = 62464, SL_VN = 79872;
DI void dn_scan(const Params& p, LAS unsigned char* L, int ch, int round) {
    int tid_ = threadIdx.x; asm volatile("" : "+v"(tid_));
    const int tid = tid_, lane = tid & 63, wid = tid >> 6, fr = lane & 15, fq = lane >> 4;
    const int eh = ch & 1, d = (ch >> 1) & 1, h = (ch >> 2) & 7, b = ch >> 5;
    LAS bf16_t* Wl = (LAS bf16_t*)(L + SL_W); LAS bf16_t* QDl = (LAS bf16_t*)(L + SL_QD); LAS bf16_t* KDTl = (LAS bf16_t*)(L + SL_KDT);
    LAS bf16_t* QKl = (LAS bf16_t*)(L + SL_QK); LAS bf16_t* STl = (LAS bf16_t*)(L + SL_ST); LAS bf16_t* VNl = (LAS bf16_t*)(L + SL_VN);
    float* sst = (float*)(p.ws + OFF_SST) + ((size_t)ch * NT + tid) * 16;
    f32x4 S[4];
#pragma unroll
    for (int ni = 0; ni < 4; ++ni) S[ni] = round == 0 ? (f32x4){0.f, 0.f, 0.f, 0.f} : *(const f32x4*)(sst + ni * 4);
    const int mi = wid >> 1, nb = (wid & 1) * 2;
    const int s0 = round * RSTEPS;
    const unsigned char* item0 = p.ws + OFF_PREP + (size_t)((((b * 8 + h) * 2 + d) * RSTEPS)) * PREP_STRIDE;
    u32x4 rW[2], rQD[2], rKD[2], rQK; bf16_t rU[2][4]; float rGL;
    int vz = 0; asm volatile("" : "+v"(vz));
#define SCAN_LOAD(it) do { const unsigned char* _p = (it); \
        rW[0] = *(const u32x4*)(_p + PI_W + tid * 16); rW[1] = *(const u32x4*)(_p + PI_W + (tid + NT) * 16); \
        rQD[0] = *(const u32x4*)(_p + PI_QD + tid * 16); rQD[1] = *(const u32x4*)(_p + PI_QD + (tid + NT) * 16); \
        rKD[0] = *(const u32x4*)(_p + PI_KDT + tid * 16); rKD[1] = *(const u32x4*)(_p + PI_KDT + (tid + NT) * 16); \
        rQK = *(const u32x4*)(_p + PI_QK + tid * 16); rGL = *(const float*)(_p + PI_GL + vz); \
        _Pragma("unroll") for (int _t = 0; _t < 2; ++_t) _Pragma("unroll") for (int _j = 0; _j < 4; ++_j) \
            rU[_t][_j] = ((const bf16_t*)(_p + PI_U))[(mi * 16 + fq * 4 + _j) * 128 + eh * 64 + (nb + _t) * 16 + fr]; } while (0)
#define SCAN_STORE() do { \
        _Pragma("unroll") for (int _i = 0; _i < 2; ++_i) { const int _x = tid + _i * NT; \
            *(LAS u32x4*)(Wl + (_x >> 4) * 136 + (_x & 15) * 8) = rW[_i]; *(LAS u32x4*)(QDl + (_x >> 4) * 136 + (_x & 15) * 8) = rQD[_i]; \
            *(LAS u32x4*)(KDTl + (_x >> 3) * 72 + (_x & 7) * 8) = rKD[_i]; } \
        *(LAS u32x4*)(QKl + (tid >> 3) * 72 + (tid & 7) * 8) = rQK; } while (0)
    SCAN_LOAD(item0);
#pragma unroll
    for (int ni = 0; ni < 4; ++ni) { u32x2 w; w.x = cvt_pk_bf16(S[ni][0], S[ni][1]); w.y = cvt_pk_bf16(S[ni][2], S[ni][3]); *(LAS u32x2*)(STl + (ni * 16 + fr) * 136 + wid * 16 + fq * 4) = w; }
    SCAN_STORE();
    __syncthreads();
    for (int si = 0; si < RSTEPS; ++si) {
        const int s = s0 + si;
        f32x4 vacc[2]; const float gl = rGL;
#pragma unroll
        for (int t = 0; t < 2; ++t) vacc[t] = (f32x4){bf2f(rU[t][0]), bf2f(rU[t][1]), bf2f(rU[t][2]), bf2f(rU[t][3])};
        if (si + 1 < RSTEPS) SCAN_LOAD(item0 + (size_t)(si + 1) * PREP_STRIDE);
#pragma unroll
        for (int k = 0; k < 4; ++k) {
            const bf16x8 a = *(const LAS bf16x8*)(Wl + (mi * 16 + fr) * 136 + k * 32 + fq * 8);
#pragma unroll
            for (int t = 0; t < 2; ++t) vacc[t] = MFMA16(a, *(const LAS bf16x8*)(STl + ((nb + t) * 16 + fr) * 136 + k * 32 + fq * 8), vacc[t]);
        }
#pragma unroll
        for (int t = 0; t < 2; ++t) { u32x2 w; w.x = cvt_pk_bf16(vacc[t][0], vacc[t][1]); w.y = cvt_pk_bf16(vacc[t][2], vacc[t][3]); *(LAS u32x2*)(VNl + ((nb + t) * 16 + fr) * 72 + mi * 16 + fq * 4) = w; }
        __syncthreads();
        if (s >= 4) {
            f32x4 oacc[2] = {(f32x4){0.f, 0.f, 0.f, 0.f}, (f32x4){0.f, 0.f, 0.f, 0.f}};
#pragma unroll
            for (int k = 0; k < 4; ++k) {
                const bf16x8 a = *(const LAS bf16x8*)(QDl + (mi * 16 + fr) * 136 + k * 32 + fq * 8);
#pragma unroll
                for (int t = 0; t < 2; ++t) oacc[t] = MFMA16(a, *(const LAS bf16x8*)(STl + ((nb + t) * 16 + fr) * 136 + k * 32 + fq * 8), oacc[t]);
            }
#pragma unroll
            for (int k = 0; k < 2; ++k) {
                const bf16x8 a = *(const LAS bf16x8*)(QKl + (mi * 16 + fr) * 72 + k * 32 + fq * 8);
#pragma unroll
                for (int t = 0; t < 2; ++t) oacc[t] = MFMA16(a, *(const LAS bf16x8*)(VNl + ((nb + t) * 16 + fr) * 72 + k * 32 + fq * 8), oacc[t]);
            }
            const int lc = d ? 31 - (s - 4) : (s - 4);
            bf16_t* od = (bf16_t*)(p.ws + OFF_ODIR) + (size_t)d * MX * 1024;
#pragma unroll
            for (int j = 0; j < 4; ++j) {
                const int i = mi * 16 + fq * 4 + j, tok = d ? 63 - i : i; const size_t row = (size_t)b * 2048 + lc * 64 + tok;
#pragma unroll
                for (int t = 0; t < 2; ++t) od[row * 1024 + h * 128 + eh * 64 + (nb + t) * 16 + fr] = (bf16_t)f2bf(oacc[t][j]);
            }
        }
#pragma unroll
        for (int ni = 0; ni < 4; ++ni) S[ni] *= gl;
#pragma unroll
        for (int k = 0; k < 2; ++k) {
            const bf16x8 a = *(const LAS bf16x8*)(KDTl + (wid * 16 + fr) * 72 + k * 32 + fq * 8);
#pragma unroll
            for (int ni = 0; ni < 4; ++ni) S[ni] = MFMA16(a, *(const LAS bf16x8*)(VNl + (ni * 16 + fr) * 72 + k * 32 + fq * 8), S[ni]);
        }
        __syncthreads();
#pragma unroll
        for (int ni = 0; ni < 4; ++ni) { u32x2 w; w.x = cvt_pk_bf16(S[ni][0], S[ni][1]); w.y = cvt_pk_bf16(S[ni][2], S[ni][3]); *(LAS u32x2*)(STl + (ni * 16 + fr) * 136 + wid * 16 + fq * 4) = w; }
        if (si + 1 < RSTEPS) SCAN_STORE();
        __syncthreads();
    }
#pragma unroll
    for (int ni = 0; ni < 4; ++ni) *(f32x4*)(sst + ni * 4) = S[ni];
#undef SCAN_LOAD
#undef SCAN_STORE
}

DI void combine_phase(const Params& p, int gw, int NGW, int lane) {
    const bf16_t* o0 = (const bf16_t*)(p.ws + OFF_ODIR); const bf16_t* o1 = o0 + (size_t)MX * 1024;
    const bf16_t* zg = (const bf16_t*)(p.ws + OFF_ZG); bf16_t* O = (bf16_t*)(p.ws + OFF_O);
    for (int r = gw; r < MX; r += NGW) {
        const size_t off = (size_t)r * 1024 + lane * 16;
        float v[16], gt[16]; float ss = 0.f;
#pragma unroll
        for (int i = 0; i < 2; ++i) {
            const u32x4 a = *(const u32x4*)(o0 + off + i * 8), c = *(const u32x4*)(o1 + off + i * 8), g = *(const u32x4*)(zg + off + i * 8);
            v[i * 8 + 0] = bflo(a.x) + bflo(c.x); v[i * 8 + 1] = bfhi(a.x) + bfhi(c.x); v[i * 8 + 2] = bflo(a.y) + bflo(c.y); v[i * 8 + 3] = bfhi(a.y) + bfhi(c.y);
            v[i * 8 + 4] = bflo(a.z) + bflo(c.z); v[i * 8 + 5] = bfhi(a.z) + bfhi(c.z); v[i * 8 + 6] = bflo(a.w) + bflo(c.w); v[i * 8 + 7] = bfhi(a.w) + bfhi(c.w);
            gt[i * 8 + 0] = bflo(g.x); gt[i * 8 + 1] = bfhi(g.x); gt[i * 8 + 2] = bflo(g.y); gt[i * 8 + 3] = bfhi(g.y);
            gt[i * 8 + 4] = bflo(g.z); gt[i * 8 + 5] = bfhi(g.z); gt[i * 8 + 6] = bflo(g.w); gt[i * 8 + 7] = bfhi(g.w);
        }
#pragma unroll
        for (int i = 0; i < 16; ++i) ss += v[i] * v[i];
        ss += __shfl_xor(ss, 1); ss += __shfl_xor(ss, 2); ss += __shfl_xor(ss, 4);
        const float rstd = rsqrtf(ss * (1.0f / 128.0f) + 1e-6f);
        const float* hg = p.head_norm_g + (lane & 7) * 16;
        float y[16];
#pragma unroll
        for (int i = 0; i < 16; ++i) y[i] = v[i] * rstd * hg[i] * gt[i];
        u32x4 w0, w1;
        w0.x = cvt_pk_bf16(y[0], y[1]); w0.y = cvt_pk_bf16(y[2], y[3]); w0.z = cvt_pk_bf16(y[4], y[5]); w0.w = cvt_pk_bf16(y[6], y[7]);
        w1.x = cvt_pk_bf16(y[8], y[9]); w1.y = cvt_pk_bf16(y[10], y[11]); w1.z = cvt_pk_bf16(y[12], y[13]); w1.w = cvt_pk_bf16(y[14], y[15]);
        bf16_t* op = O + (size_t)r * D + lane * 16;
        *(u32x4*)op = w0; *(u32x4*)(op + 8) = w1;
    }
}

template <class Epi> DI void run_gemm(LAS unsigned char* L, const bf16_t* A, const bf16_t* Bt, int M, int N, int K, const Epi& E) {
    pg8::Gemm g{A, Bt, M, N, K}; pg8::StaticOrder S; S.init(M, N, (int)gridDim.x, (int)blockIdx.x);
    pg8::gemm_phase<Epi, pg8::StaticOrder, false>(L, g, S, E, nullptr);
    __syncthreads();
}

__global__ void __launch_bounds__(NT, 2) fwd_megakernel(Params p_unused) {
    extern __shared__ __attribute__((aligned(16))) unsigned char lds_raw[];
    LAS unsigned char* L = (LAS unsigned char*)lds_raw;
    cg::grid_group grid = cg::this_grid();
#define GSYNC() do { __builtin_amdgcn_fence(__ATOMIC_RELEASE, "agent"); grid.sync(); __builtin_amdgcn_fence(__ATOMIC_ACQUIRE, "agent"); } while (0)
#define TIDS const int tid = threadIdx.x, lane = tid & 63, wid = __builtin_amdgcn_readfirstlane(tid >> 6); const int G = gridDim.x, bid = blockIdx.x, gw = bid * 8 + wid, NGW = G * 8; (void)lane; (void)gw; (void)NGW; (void)G; (void)bid
    { TIDS; const Params p = load_params();
      mod_gemv(p, L, bid, G);
      convert_weights(p.ffn1_w_in, D, NUP, NUP, 1, (bf16_t*)(p.ws + OFF_WT_FFN_IN), L, gw, NGW, wid, lane);
      convert_weights(p.ffn1_w_out, FF, D, D, 0, (bf16_t*)(p.ws + OFF_WT_FFN_OUT), L, gw, NGW, wid, lane);
      convert_weights(p.w_in, D, 6176, NIN, 2, (bf16_t*)(p.ws + OFF_WT_IN), L, gw, NGW, wid, lane);
      convert_weights(p.w_out, D, D, D, 0, (bf16_t*)(p.ws + OFF_WT_OUT), L, gw, NGW, wid, lane); }
    GSYNC();
    { TIDS; const Params p = load_params();
      norm_mod_phase(p.x, p.ctx, MALL, p.norm_g, (const float*)(p.ws + OFF_MOD), 0, (bf16_t*)(p.ws + OFF_H), gw, NGW, lane); }
    GSYNC();
    { const Params p = load_params();
      run_gemm(L, (const bf16_t*)(p.ws + OFF_H), (const bf16_t*)(p.ws + OFF_WT_FFN_IN), MALL, NUP, D, EpiSwiglu{(bf16_t*)(p.ws + OFF_G)}); }
    GSYNC();
    { const Params p = load_params();
      run_gemm(L, (const bf16_t*)(p.ws + OFF_G), (const bf16_t*)(p.ws + OFF_WT_FFN_OUT), MALL, D, FF, EpiResid{p.x, p.ctx, p.out, (float*)(p.ws + OFF_CTX1), (const float*)(p.ws + OFF_MOD), 2, 0.5f}); }
    GSYNC();
    { TIDS; const Params p = load_params();
      norm_mod_phase(p.out, (const float*)(p.ws + OFF_CTX1), MALL, p.norm_g + D, (const float*)(p.ws + OFF_MOD), 3, (bf16_t*)(p.ws + OFF_H), gw, NGW, lane);
      convert_weights(p.ffn2_w_in, D, NUP, NUP, 1, (bf16_t*)(p.ws + OFF_WT_FFN_IN), L, gw, NGW, wid, lane);
      convert_weights(p.ffn2_w_out, FF, D, D, 0, (bf16_t*)(p.ws + OFF_WT_FFN_OUT), L, gw, NGW, wid, lane); }
    GSYNC();
    { const Params p = load_params();
      run_gemm(L, (const bf16_t*)(p.ws + OFF_H), (const bf16_t*)(p.ws + OFF_WT_IN), MALL, NIN, D, EpiInproj{p.ws}); }
    GSYNC();
    for (int round = 0; round < NROUND; ++round) {
        { const Params p = load_params(); const int G = gridDim.x, bid = blockIdx.x;
          const int nitems = PREP_ITEMS + (round == 0 ? 1024 : 0);
          for (int it = bid; it < nitems; it += G) {
              if (it < PREP_ITEMS) { const int si = it % RSTEPS, chn = it / RSTEPS; dn_prep_item(p, L, chn >> 4, (chn >> 1) & 7, chn & 1, round * RSTEPS + si, it); }
              else { const int m = it - PREP_ITEMS; chunk_mlp_item(p, L, m >> 7, (m >> 3) & 15, m & 7); }
          } }
        GSYNC();
        { const Params p = load_params(); const int G = gridDim.x, bid = blockIdx.x;
          for (int ch = bid; ch < 256; ch += G) { dn_scan(p, L, ch, round); __syncthreads(); } }
        GSYNC();
    }
    { TIDS; const Params p = load_params(); combine_phase(p, gw, NGW, lane); }
    GSYNC();
    { const Params p = load_params();
      run_gemm(L, (const bf16_t*)(p.ws + OFF_O), (const bf16_t*)(p.ws + OFF_WT_OUT), MX, D, D, EpiResid{p.out, p.out, p.out, p.out, (const float*)(p.ws + OFF_MOD), 5, 1.0f}); }
    GSYNC();
    { TIDS; const Params p = load_params();
      norm_mod_phase(p.out, p.out, MX, p.norm_g + 2 * D, (const float*)(p.ws + OFF_MOD), 6, (bf16_t*)(p.ws + OFF_H), gw, NGW, lane); }
    GSYNC();
    { const Params p = load_params();
      run_gemm(L, (const bf16_t*)(p.ws + OFF_H), (const bf16_t*)(p.ws + OFF_WT_FFN_IN), MX, NUP, D, EpiSwiglu{(bf16_t*)(p.ws + OFF_G)}); }
    GSYNC();
    { const Params p = load_params();
      run_gemm(L, (const bf16_t*)(p.ws + OFF_G), (const bf16_t*)(p.ws + OFF_WT_FFN_OUT), MX, D, FF, EpiResid{p.out, p.out, p.out, p.out, (const float*)(p.ws + OFF_MOD), 8, 0.5f}); }
    GSYNC();
    { TIDS; const Params p = load_params(); final_norm_phase(p.out, p.final_g, gw, NGW, lane); }
}

extern "C" void kernel_launch(void* const* d_in, const int* in_sizes, int n_in, void* d_out, int out_size, void* d_ws, size_t ws_size, hipStream_t stream) {
    static int grid_blocks = 0;
    if (grid_blocks == 0) {
        if (n_in != 21 || ws_size < WS_END) { fprintf(stderr, "kernel_launch: unexpected n_in %d or ws_size %zu < %zu\n", n_in, ws_size, (size_t)WS_END); grid_blocks = -1; return; }
        int dev = 0, cus = 0, per_cu = 0;
        hipGetDevice(&dev);
        hipDeviceGetAttribute(&cus, hipDeviceAttributeMultiprocessorCount, dev);
        hipFuncSetAttribute((const void*)fwd_megakernel, hipFuncAttributeMaxDynamicSharedMemorySize, LDS_BYTES);
        hipOccupancyMaxActiveBlocksPerMultiprocessor(&per_cu, (const void*)fwd_megakernel, NT, LDS_BYTES);
        if (per_cu < 1) per_cu = 1;
        grid_blocks = cus * per_cu;
        (void)hipGetLastError();
    }
    if (grid_blocks < 0) return;
    Params p{};
    const float** pp = (const float**)&p;
    for (int i = 0; i < 21; ++i) pp[i] = (const float*)d_in[i];
    p.out = (float*)d_out; p.ws = (unsigned char*)d_ws;
    void* args[] = {&p};
    hipError_t e = hipLaunchCooperativeKernel((const void*)fwd_megakernel, dim3(grid_blocks), dim3(NT), args, LDS_BYTES, stream);
    if (e != hipSuccess) fprintf(stderr, "cooperative launch failed: %s (grid %d)\n", hipGetErrorString(e), grid_blocks);
}
```

```cpp
#include <hip/hip_runtime.h>
#include <hip/hip_cooperative_groups.h>
#include <cstdio>
namespace cg = cooperative_groups;
namespace pg8 {
#define PG8_LAS __attribute__((address_space(3)))
typedef unsigned short bf16_t;
typedef short bf16x8 __attribute__((ext_vector_type(8)));
typedef float f32x4 __attribute__((ext_vector_type(4)));
typedef unsigned u32x4 __attribute__((ext_vector_type(4)));
constexpr int BM = 256, BK = 64, HALF = 128, HTB = HALF * BK * 2  , STAGE_BYTES = 8 * HTB, NXCD = 8, WGM = 8;

__host__ __device__ __forceinline__ int lds_byte(int r, int c) { const int st = (r >> 4) * 2 + (c >> 5), rr = r & 15, cc = c & 31, ob = rr * 64 + cc * 2; return st * 1024 + (ob ^ (((ob >> 9) & 1) << 5)); }
__host__ __device__ __forceinline__ void stage_rc(int b, int& R, int& C) { const int st = b / 1024, sb = b % 1024, swz = sb ^ (((sb >> 9) & 1) << 5); R = (st >> 1) * 16 + swz / 64; C = (st & 1) * 32 + (swz % 64) / 2; }
__host__ __device__ __forceinline__ int perm32(int rho) { const int n = rho >> 4, i = rho & 15; return 8 * (i >> 2) + 4 * n + (i & 3); }

struct Unit { int pm, pn; };
struct Gemm { const bf16_t* A; const bf16_t* Bt; int M, N, K; int ld; };

struct StaticOrder {
    int nM, nN, nwg, G, c;
    __host__ __device__ void init(int M, int N, int G_, int c_) { nM = M / BM; nN = N / BM; nwg = nM * nN; G = G_; c = c_; }
    __host__ __device__ bool next(int i, Unit& u) const {
        const long L = (long)i * G + c; if (L >= nwg) return false;
        int wgid = (int)L; { const int q = nwg / NXCD, r = nwg % NXCD, xcd = wgid % NXCD, off = wgid / NXCD; wgid = (xcd < r ? xcd * (q + 1) : r * (q + 1) + (xcd - r) * q) + off; }
        const int nig = WGM * nN, gid = wgid / nig, fm = gid * WGM, gsz = (nM - fm) < WGM ? (nM - fm) : WGM;
        u.pm = fm + ((wgid % nig) % gsz); u.pn = (wgid % nig) / gsz; return true;
    }
    __device__ __forceinline__ void a_ready(const Unit&) const {}
    __device__ __forceinline__ void done(const Unit&) const {}
};
typedef float f32x2_cv __attribute__((ext_vector_type(2)));
typedef __bf16 bf16x2_cv __attribute__((ext_vector_type(2)));
__device__ __forceinline__ unsigned cvt_pk_bf16(float lo, float hi) { const f32x2_cv v = {lo, hi}; const bf16x2_cv r = __builtin_convertvector(v, bf16x2_cv); return __builtin_bit_cast(unsigned, r); }
template <class Epi, class Sched, bool STAMP = false>
__device__ __forceinline__ void gemm_phase(PG8_LAS unsigned char* lds, const Gemm g, const Sched& S, const Epi& E, unsigned long long* stamps) {
    const int tid = threadIdx.x, wid = __builtin_amdgcn_readfirstlane(tid >> 6), lane = tid & 63, wr = wid >> 2, wc = wid & 3, fr = lane & 15, fq = lane >> 4;
    const int K = g.K, nt = K / BK, LD = g.ld ? g.ld : g.K;
    int ts_lo = 0, ts_hi = 0, nts = 0; const unsigned long long rt_entry = STAMP ? (unsigned long long)wall_clock64() : 0ull;
#define PG8_STAMP() do { if (STAMP && wid == 0 && nts < 64) { const unsigned long long _c = (unsigned long long)clock64(); \
        ts_lo = (lane == nts) ? (int)(unsigned)_c : ts_lo; ts_hi = (lane == nts) ? (int)(unsigned)(_c >> 32) : ts_hi; ++nts; } } while (0)
    PG8_STAMP();
    unsigned voffA[2], voffB[2];
#pragma unroll
    for (int i = 0; i < 2; ++i) { int R, C; stage_rc(tid * 16 + i * 8192, R, C); const int Rb = Epi::PERM ? ((R & ~31) + perm32(R & 31)) : R;
        voffA[i] = (unsigned)(R * LD + C) * 2u; voffB[i] = (unsigned)(Rb * LD + C) * 2u; }
    const size_t kstep = (size_t)(BK * 2);
    const size_t hstep = (size_t)HALF * LD * 2;
    const size_t tstep = 2 * hstep;
    const unsigned ldsw = (unsigned)wid * 1024u;
    const int aoff = lds_byte(wr * 64 + fr, fq * 8), boff = lds_byte(wc * 32 + fr, fq * 8);
#define PG8_SA(b, h) (((b) * 2 + (h)) * HTB)
#define PG8_SB(b, h) ((4 + (b) * 2 + (h)) * HTB)
#define PG8_STAGE(bufoff, gbase, voff) do { _Pragma("unroll") for (int _i = 0; _i < 2; ++_i) \
        __builtin_amdgcn_global_load_lds((const unsigned*)((const char*)(gbase) + (voff)[_i]), (PG8_LAS unsigned*)(lds + (bufoff) + ldsw + _i * 8192), 16, 0, 0); } while (0)
#define PG8_LDA(dst, b, h) do { _Pragma("unroll") for (int m = 0; m < 4; ++m) _Pragma("unroll") for (int k = 0; k < 2; ++k) dst[m][k] = *(const PG8_LAS bf16x8*)(lds + PG8_SA(b, h) + aoff + m * 2048 + k * 1024); } while (0)
#define PG8_LDB(dst, b, h) do { _Pragma("unroll") for (int n = 0; n < 2; ++n) _Pragma("unroll") for (int k = 0; k < 2; ++k) dst[n][k] = *(const PG8_LAS bf16x8*)(lds + PG8_SB(b, h) + boff + n * 2048 + k * 1024); } while (0)
#define PG8_MMA(ai, bj, At, Bt) do { __builtin_amdgcn_s_setprio(1); _Pragma("unroll") for (int m = 0; m < 4; ++m) _Pragma("unroll") for (int n = 0; n < 2; ++n) _Pragma("unroll") for (int k = 0; k < 2; ++k) \
        acc[ai][bj][m][n] = __builtin_amdgcn_mfma_f32_16x16x32_bf16(Bt[n][k], At[m][k], acc[ai][bj][m][n], 0, 0, 0); __builtin_amdgcn_s_setprio(0); } while (0)
#define PG8_WAIT_V(n) asm volatile("s_waitcnt vmcnt(" #n ")" ::: "memory")
#define PG8_WAIT_L(n) asm volatile("s_waitcnt lgkmcnt(" #n ")" ::: "memory")
#define PG8_BAR __builtin_amdgcn_s_barrier()
#define PG8_SCHED __builtin_amdgcn_sched_barrier(0)
    Unit cur, nxt; int ui = 0;
    if (!S.next(0, cur)) return;
    f32x4 acc[2][2][4][2];
#pragma unroll
    for (int a = 0; a < 2; ++a)
#pragma unroll
        for (int b = 0; b < 2; ++b)
#pragma unroll
            for (int m = 0; m < 4; ++m)
#pragma unroll
                for (int n = 0; n < 2; ++n) acc[a][b][m][n] = (f32x4){0.f, 0.f, 0.f, 0.f};
    bf16x8 At[4][2], B0[2][2], B1[2][2];
    const char* cA = (const char*)g.A + (size_t)cur.pm * tstep; const char* cB = (const char*)g.Bt + (size_t)cur.pn * tstep;
    S.a_ready(cur);
    PG8_STAGE(PG8_SB(0, 0), cB, voffB); PG8_STAGE(PG8_SA(0, 0), cA, voffA); PG8_STAGE(PG8_SB(0, 1), cB + hstep, voffB); PG8_STAGE(PG8_SA(0, 1), cA + hstep, voffA);
    if (wr == 1) PG8_BAR;
    PG8_WAIT_V(4); PG8_BAR;
    PG8_STAGE(PG8_SB(1, 0), cB + kstep, voffB); PG8_STAGE(PG8_SA(1, 0), cA + kstep, voffA); PG8_STAGE(PG8_SB(1, 1), cB + hstep + kstep, voffB);
    PG8_WAIT_V(6); PG8_BAR;
    PG8_STAMP();
    for (;;) {
        const bool has_next = S.next(ui + 1, nxt);
        const char* nA = has_next ? (const char*)g.A + (size_t)nxt.pm * tstep : cA; const char* nB = has_next ? (const char*)g.Bt + (size_t)nxt.pn * tstep : cB;
        for (int t = 0; t < nt; t += 2) {
            const bool last = (t == nt - 2);
            const char* a1 = cA + (size_t)(t + 1) * kstep;
            const char* a2 = last ? nA : cA + (size_t)(t + 2) * kstep; const char* b2 = last ? nB : cB + (size_t)(t + 2) * kstep;
            const char* a3 = a2 + kstep; const char* b3 = b2 + kstep;
            if (last && has_next) S.a_ready(nxt);
            PG8_LDB(B0, 0, 0); PG8_SCHED; PG8_LDA(At, 0, 0); PG8_STAGE(PG8_SA(1, 1), a1 + hstep, voffA);
            PG8_WAIT_L(8); PG8_BAR; PG8_WAIT_L(0); PG8_MMA(0, 0, At, B0); PG8_BAR; PG8_SCHED;
            PG8_LDB(B1, 0, 1); PG8_STAGE(PG8_SB(0, 0), b2, voffB);
            PG8_BAR; PG8_WAIT_L(0); PG8_MMA(0, 1, At, B1); PG8_BAR;
            PG8_LDA(At, 0, 1); PG8_STAGE(PG8_SA(0, 0), a2, voffA);
            PG8_BAR; PG8_WAIT_L(0); PG8_MMA(1, 0, At, B0); PG8_BAR; PG8_SCHED;
            PG8_STAGE(PG8_SB(0, 1), b2 + hstep, voffB);
            PG8_WAIT_V(6); PG8_BAR; PG8_MMA(1, 1, At, B1); PG8_BAR;
            PG8_LDB(B0, 1, 0); PG8_SCHED; PG8_LDA(At, 1, 0); PG8_STAGE(PG8_SA(0, 1), a2 + hstep, voffA);
            PG8_WAIT_L(8); PG8_BAR; PG8_WAIT_L(0); PG8_MMA(0, 0, At, B0); PG8_BAR; PG8_SCHED;
            PG8_LDB(B1, 1, 1); PG8_STAGE(PG8_SB(1, 0), b3, voffB);
            PG8_BAR; PG8_WAIT_L(0); PG8_MMA(0, 1, At, B1); PG8_BAR;
            PG8_LDA(At, 1, 1); PG8_STAGE(PG8_SA(1, 0), a3, voffA);
            PG8_BAR; PG8_WAIT_L(0); PG8_MMA(1, 0, At, B0); PG8_BAR; PG8_SCHED;
            PG8_STAGE(PG8_SB(1, 1), b3 + hstep, voffB);
            PG8_WAIT_V(6); PG8_BAR; PG8_MMA(1, 1, At, B1); PG8_BAR;
        }
        PG8_STAMP();
        if constexpr (!Epi::AFTER_DRAIN) { E(acc, cur, wr, wc, fr, fq); S.done(cur); }
        PG8_STAMP();
        if (!has_next) break;
#pragma unroll
        for (int a = 0; a < 2; ++a)
#pragma unroll
            for (int b = 0; b < 2; ++b)
#pragma unroll
                for (int m = 0; m < 4; ++m)
#pragma unroll
                    for (int n = 0; n < 2; ++n) acc[a][b][m][n] = (f32x4){0.f, 0.f, 0.f, 0.f};
        cur = nxt; cA = nA; cB = nB; ++ui;
    }
    PG8_WAIT_V(0);
    if (wr == 0) PG8_BAR;
    PG8_BAR;
    if constexpr (Epi::AFTER_DRAIN) { E.fused(acc, cur, wr, wc, fr, fq, lds, wid, lane); S.done(cur); }
    PG8_STAMP();
    if (STAMP && wid == 0) { stamps[lane] = lane < nts ? (((unsigned long long)(unsigned)ts_hi << 32) | (unsigned)ts_lo) : 0ull;
        if (lane == 62) stamps[62] = rt_entry; if (lane == 63) stamps[63] = (unsigned long long)wall_clock64(); }
#undef PG8_STAMP
#undef PG8_SA
#undef PG8_SB
#undef PG8_STAGE
#undef PG8_LDA
#undef PG8_LDB
#undef PG8_MMA
#undef PG8_WAIT_V
#undef PG8_WAIT_L
#undef PG8_BAR
#undef PG8_SCHED
}
}

using pg8::bf16_t; using pg8::bf16x8; using pg8::f32x4; using pg8::u32x4; using pg8::Unit; using pg8::cvt_pk_bf16;
typedef unsigned u32x2 __attribute__((ext_vector_type(2)));
#define DI __device__ __forceinline__
#define LAS __attribute__((address_space(3)))
#define MFMA16(a, b, c) __builtin_amdgcn_mfma_f32_16x16x32_bf16((a), (b), (c), 0, 0, 0)

constexpr int NT = 512;
constexpr int D = 2048, FF = 5504, NUP = 11008, NIN = 6400;
constexpr int MX = 16384, MC = 2048, MALL = 18432;
constexpr int NMOD = 18432;
constexpr int LDS_BYTES = 159744;

constexpr size_t OFF_WT_FFN_IN = 0;
constexpr size_t OFF_WT_FFN_OUT = OFF_WT_FFN_IN + (size_t)NUP * D * 2;
constexpr size_t OFF_WT_OUT = OFF_WT_FFN_OUT + (size_t)D * FF * 2;
constexpr size_t OFF_MOD = OFF_WT_OUT + (size_t)D * D * 2;
constexpr size_t OFF_AB = OFF_MOD + (size_t)9 * NMOD * 4;
constexpr size_t OFF_SST = OFF_AB + (size_t)MALL * 32 * 4;
constexpr size_t OFF_Z0 = OFF_SST + (size_t)256 * 8192 * 4;
constexpr size_t OFF_G = OFF_Z0;
constexpr size_t OFF_ZQKV = OFF_Z0;
constexpr size_t OFF_ZG = OFF_ZQKV + (size_t)MALL * 3072 * 2;
constexpr size_t OFF_ZU = OFF_ZG + (size_t)MX * 1024 * 2;
constexpr size_t OFF_ZV = OFF_ZU + (size_t)MX * 1024 * 2;
constexpr size_t OFF_H = OFF_ZV + (size_t)MX * 1024 * 2;
constexpr size_t OFF_ODIR = OFF_H;
constexpr size_t OFF_WT_IN = OFF_H + (size_t)MALL * D * 2;
constexpr size_t OFF_CTX1 = OFF_WT_IN + (size_t)NIN * D * 2;
constexpr size_t OFF_PREP = OFF_WT_IN;
constexpr int PREP_STRIDE = 73984;
constexpr int PI_W = 0, PI_U = 16384, PI_QD = 32768, PI_KDT = 49152, PI_QK = 65536, PI_GL = 73728;
constexpr int NSTEP = 36, NROUND = 2, RSTEPS = NSTEP / NROUND;
constexpr int PREP_ITEMS = 8 * 8 * 2 * RSTEPS;
constexpr size_t OFF_O = OFF_PREP + (size_t)PREP_ITEMS * PREP_STRIDE;
constexpr size_t OFF_BAR = OFF_O + (size_t)MX * D * 2;
constexpr size_t WS_END = OFF_BAR + 16384;
static_assert(OFF_G + (size_t)MALL * FF * 2 <= OFF_H, "G vs H");
static_assert((size_t)2 * MX * 1024 * 2 <= (size_t)MALL * D * 2, "ODIR fits H");
static_assert(OFF_CTX1 + (size_t)2 * MC * D * 4 <= OFF_O, "ctx1 / split-K partials");

struct Params {
    const float *x, *c, *ctx, *c_ctx, *w_mod, *b_mod, *norm_g, *ffn1_w_in, *ffn1_w_out, *w_in, *conv_w, *a_log, *dt_bias, *head_norm_g,
        *spatial_w, *spatial_b, *mlp_norm_g, *w_out, *ffn2_w_in, *ffn2_w_out, *final_g;
    float* out; unsigned char* ws;
};

typedef const __attribute__((address_space(4))) unsigned long long* kargp_t;
typedef __attribute__((address_space(1))) unsigned char* gptr_t;
DI Params load_params() {
    kargp_t k = (kargp_t)__builtin_amdgcn_kernarg_segment_ptr();
    asm volatile("" : "+s"(k));
    Params q;
#define LP(i) ((gptr_t)k[i])
    q.x = (const float*)LP(0); q.c = (const float*)LP(1); q.ctx = (const float*)LP(2); q.c_ctx = (const float*)LP(3); q.w_mod = (const float*)LP(4);
    q.b_mod = (const float*)LP(5); q.norm_g = (const float*)LP(6); q.ffn1_w_in = (const float*)LP(7); q.ffn1_w_out = (const float*)LP(8); q.w_in = (const float*)LP(9);
    q.conv_w = (const float*)LP(10); q.a_log = (const float*)LP(11); q.dt_bias = (const float*)LP(12); q.head_norm_g = (const float*)LP(13); q.spatial_w = (const float*)LP(14);
    q.spatial_b = (const float*)LP(15); q.mlp_norm_g = (const float*)LP(16); q.w_out = (const float*)LP(17); q.ffn2_w_in = (const float*)LP(18); q.ffn2_w_out = (const float*)LP(19);
    q.final_g = (const float*)LP(20); q.out = (float*)LP(21); q.ws = (unsigned char*)LP(22);
#undef LP
    return q;
}
DI float bflo(unsigned u) { return __uint_as_float(u << 16); }
DI float bfhi(unsigned u) { return __uint_as_float(u & 0xffff0000u); }
DI float bf2f(bf16_t b) { return __uint_as_float(((unsigned)b) << 16); }
DI unsigned f2bf(float f) { unsigned u = __float_as_uint(f); return (u + 0x7fffu + ((u >> 16) & 1u)) >> 16; }
DI float silu_f(float x) { return x * __builtin_amdgcn_rcpf(1.0f + __expf(-x)); }
DI float gelu_f(float x) { const float u = 1.5957691216057308f * (x + 0.044715f * x * x * x); return x * __builtin_amdgcn_rcpf(1.0f + __expf(-u)); }
DI float wave_sum(float v) {
#pragma unroll
    for (int o = 1; o < 64; o <<= 1) v += __shfl_xor(v, o);
    return v;
}

struct EpiSwiglu {
    static constexpr bool PERM = true, AFTER_DRAIN = false;
    bf16_t* G;
    DI void operator()(const f32x4 (&acc)[2][2][4][2], const Unit& u, int wr, int wc, int fr, int fq) const {
        const int row0 = u.pm * 256 + wr * 64 + fr, col0 = u.pn * 128 + wc * 32 + 8 * fq;
#pragma unroll
        for (int ai = 0; ai < 2; ++ai)
#pragma unroll
            for (int m = 0; m < 4; ++m) {
                const f32x4 a0 = acc[ai][0][m][0], a1 = acc[ai][0][m][1], b0 = acc[ai][1][m][0], b1 = acc[ai][1][m][1];
                u32x4 w;
                w.x = cvt_pk_bf16(silu_f(a0[0]) * b0[0], silu_f(a0[1]) * b0[1]); w.y = cvt_pk_bf16(silu_f(a0[2]) * b0[2], silu_f(a0[3]) * b0[3]);
                w.z = cvt_pk_bf16(silu_f(a1[0]) * b1[0], silu_f(a1[1]) * b1[1]); w.w = cvt_pk_bf16(silu_f(a1[2]) * b1[2], silu_f(a1[3]) * b1[3]);
                *(u32x4*)(G + (size_t)(row0 + ai * 128 + m * 16) * FF + col0) = w;
            }
    }
};
struct EpiResid {
    static constexpr bool PERM = false, AFTER_DRAIN = false;
    const float* srcx; const float* srcc; float* dstx; float* dstc; const float* mod; int gate_idx; float coef; int ctx_only;
    DI void operator()(const f32x4 (&acc)[2][2][4][2], const Unit& u, int wr, int wc, int fr, int fq) const {
        const bool isc = ctx_only || u.pm >= 64; const int mb = isc ? 8 : (u.pm >> 3);
        const int row0 = ((isc && !ctx_only) ? (u.pm - 64) : u.pm) * 256 + wr * 64 + fr, col0 = u.pn * 256 + wc * 32 + 4 * fq;
        const float* src = isc ? srcc : srcx; float* dst = isc ? dstc : dstx;
        const float* gate = mod + (size_t)mb * NMOD + gate_idx * D + col0;
        f32x4 gv[2][2];
#pragma unroll
        for (int bj = 0; bj < 2; ++bj)
#pragma unroll
            for (int n = 0; n < 2; ++n) gv[bj][n] = *(const f32x4*)(gate + bj * 128 + n * 16) * coef;
#pragma unroll
        for (int ai = 0; ai < 2; ++ai)
#pragma unroll
            for (int m = 0; m < 4; ++m) {
                const size_t off = (size_t)(row0 + ai * 128 + m * 16) * D + col0;
#pragma unroll
                for (int bj = 0; bj < 2; ++bj)
#pragma unroll
                    for (int n = 0; n < 2; ++n) {
                        const f32x4 s = *(const f32x4*)(src + off + bj * 128 + n * 16);
                        *(f32x4*)(dst + off + bj * 128 + n * 16) = s + gv[bj][n] * acc[ai][bj][m][n];
                    }
                if (m & 1) asm volatile("" ::: "memory");
            }
    }
};
struct EpiPartial {
    static constexpr bool PERM = false, AFTER_DRAIN = false;
    float* P;
    DI void operator()(const f32x4 (&acc)[2][2][4][2], const Unit& u, int wr, int wc, int fr, int fq) const {
        const int row0 = u.pm * 256 + wr * 64 + fr, col0 = u.pn * 256 + wc * 32 + 4 * fq;
#pragma unroll
        for (int ai = 0; ai < 2; ++ai)
#pragma unroll
            for (int m = 0; m < 4; ++m) {
                float* rp = P + (size_t)(row0 + ai * 128 + m * 16) * D + col0;
#pragma unroll
                for (int bj = 0; bj < 2; ++bj)
#pragma unroll
                    for (int n = 0; n < 2; ++n) *(f32x4*)(rp + bj * 128 + n * 16) = acc[ai][bj][m][n];
            }
    }
};
struct EpiInproj {
    static constexpr bool PERM = true, AFTER_DRAIN = false;
    unsigned char* ws;
    DI void operator()(const f32x4 (&acc)[2][2][4][2], const Unit& u, int wr, int wc, int fr, int fq) const {
        const int row0 = u.pm * 256 + wr * 64 + fr;
        if (u.pn == 24) {
            if (wc == 0) {
                float* AB = (float*)(ws + OFF_AB);
#pragma unroll
                for (int ai = 0; ai < 2; ++ai)
#pragma unroll
                    for (int m = 0; m < 4; ++m) {
                        float* rp = AB + (size_t)(row0 + ai * 128 + m * 16) * 32 + 8 * fq;
                        *(f32x4*)rp = acc[ai][0][m][0]; *(f32x4*)(rp + 4) = acc[ai][0][m][1];
                    }
            }
            return;
        }
        if (u.pn >= 12 && u.pm >= 64) return;
        int act, ld, colt; bf16_t* base;
        if (u.pn < 12) { act = 0; ld = 3072; colt = u.pn * 256; base = (bf16_t*)(ws + OFF_ZQKV); }
        else if (u.pn < 16) { act = 1; ld = 1024; colt = (u.pn - 12) * 256; base = (bf16_t*)(ws + OFF_ZG); }
        else if (u.pn < 20) { act = 2; ld = 1024; colt = (u.pn - 16) * 256; base = (bf16_t*)(ws + OFF_ZU); }
        else { act = 2; ld = 1024; colt = (u.pn - 20) * 256; base = (bf16_t*)(ws + OFF_ZV); }
        const int col0 = colt + wc * 32 + 8 * fq;
#pragma unroll
        for (int ai = 0; ai < 2; ++ai)
#pragma unroll
            for (int m = 0; m < 4; ++m) {
                bf16_t* rowp = base + (size_t)(row0 + ai * 128 + m * 16) * ld + col0;
#pragma unroll
                for (int bj = 0; bj < 2; ++bj) {
                    f32x4 v0 = acc[ai][bj][m][0], v1 = acc[ai][bj][m][1];
                    if (act == 1) {
#pragma unroll
                        for (int j = 0; j < 4; ++j) { v0[j] = silu_f(v0[j]); v1[j] = silu_f(v1[j]); }
                    } else if (act == 2) {
#pragma unroll
                        for (int j = 0; j < 4; ++j) { v0[j] = gelu_f(v0[j]); v1[j] = gelu_f(v1[j]); }
                    }
                    u32x4 w; w.x = cvt_pk_bf16(v0[0], v0[1]); w.y = cvt_pk_bf16(v0[2], v0[3]); w.z = cvt_pk_bf16(v1[0], v1[1]); w.w = cvt_pk_bf16(v1[2], v1[3]);
                    *(u32x4*)(rowp + bj * 128) = w;
                }
            }
    }
};

DI int src_col(int mode, int n) {
    if (mode == 1) { const int pn = n >> 8, j = n & 255; return j < 128 ? pn * 128 + j : FF + pn * 128 + (j - 128); }
    if (mode == 2) { if (n < 4096) return n; if (n < 6144) return n + 32; if (n < 6176) return n - 6144 + 4096; return -1; }
    return n;
}
DI void transpose_item(const float* W, int K, int N, int Ndst, int mode, bf16_t* WT, LAS float* scr, int item, int lane) {
    const int nblk = Ndst / 64, kb = item / nblk, nb = item % nblk, k0 = 64 * kb, n0 = 64 * nb;
    const int rsub = lane >> 4, cg = lane & 15;
    const int s0 = src_col(mode, n0 + cg * 4);
    f32x4 v[16];
    if (s0 >= 0) {
        const float* wp = W + (size_t)(k0 + rsub) * N + s0;
#pragma unroll
        for (int i = 0; i < 16; ++i) v[i] = __builtin_nontemporal_load((const f32x4*)(wp + (size_t)(i * 4) * N));
    } else {
#pragma unroll
        for (int i = 0; i < 16; ++i) v[i] = (f32x4){0.f, 0.f, 0.f, 0.f};
    }
#pragma unroll
    for (int i = 0; i < 16; ++i) { LAS float* d = scr + (i * 4 + rsub) * 65 + cg * 4; d[0] = v[i].x; d[1] = v[i].y; d[2] = v[i].z; d[3] = v[i].w; }
    asm volatile("s_waitcnt lgkmcnt(0)" ::: "memory");
    const int c = lane & 7, nl = lane >> 3;
#pragma unroll
    for (int j = 0; j < 8; ++j) {
        const int n = nl + 8 * j; const LAS float* sp = scr + (8 * c) * 65 + n;
        u32x4 o; o.x = cvt_pk_bf16(sp[0 * 65], sp[1 * 65]); o.y = cvt_pk_bf16(sp[2 * 65], sp[3 * 65]); o.z = cvt_pk_bf16(sp[4 * 65], sp[5 * 65]); o.w = cvt_pk_bf16(sp[6 * 65], sp[7 * 65]);
        *(u32x4*)(WT + (size_t)(n0 + n) * K + k0 + 8 * c) = o;
    }
    asm volatile("s_waitcnt lgkmcnt(0)" ::: "memory");
}
DI void convert_weights(const float* W, int K, int N, int Ndst, int mode, bf16_t* WT, LAS unsigned char* L, int gw, int NGW, int wid, int lane, int sel = 0, int nsel = 1) {
    LAS float* scr = (LAS float*)(L + wid * 16640);
    const int nitems = (K / 64) * (Ndst / 64);
    for (int it = gw * nsel + sel; it < nitems; it += NGW * nsel) transpose_item(W, K, N, Ndst, mode, WT, scr, it, lane);
}

DI void mod_gemv(const Params& p, LAS unsigned char* L, int bid, int G) {
    const int tid = threadIdx.x, lane = tid & 63, wid = tid >> 6;
    LAS float* sc = (LAS float*)L;
    LAS float* red = (LAS float*)(L + 9 * 2048 * 4);
    for (int i = tid; i < 9 * 2048; i += NT) { const int r = i >> 11, k = i & 2047; const float v = r < 8 ? p.c[r * 2048 + k] : p.c_ctx[k]; sc[i] = silu_f(v); }
    __syncthreads();
    float* MOD = (float*)(p.ws + OFF_MOD);
    const int cgi = lane & 15, ksub = lane >> 4, ks = wid * 4 + ksub;
    for (int item = bid; item < NMOD / 64; item += G) {
        const int n0 = item * 64;
        f32x4 acc[9];
#pragma unroll
        for (int r = 0; r < 9; ++r) acc[r] = (f32x4){0.f, 0.f, 0.f, 0.f};
        const float* wp = p.w_mod + (size_t)(ks * 64) * NMOD + n0 + cgi * 4;
#pragma unroll 8
        for (int kk = 0; kk < 64; ++kk) {
            const f32x4 wv = __builtin_nontemporal_load((const f32x4*)(wp + (size_t)kk * NMOD));
#pragma unroll
            for (int r = 0; r < 9; ++r) acc[r] += wv * sc[r * 2048 + ks * 64 + kk];
        }
#pragma unroll
        for (int r = 0; r < 9; ++r)
#pragma unroll
            for (int j = 0; j < 4; ++j) { float v = acc[r][j]; v += __shfl_xor(v, 16); v += __shfl_xor(v, 32); acc[r][j] = v; }
        if (ksub == 0) {
#pragma unroll
            for (int r = 0; r < 9; ++r) *(LAS f32x4*)(red + (wid * 9 + r) * 64 + cgi * 4) = acc[r];
        }
        __syncthreads();
        for (int i = tid; i < 9 * 64; i += NT) {
            const int r = i >> 6, col = i & 63; float s = p.b_mod[n0 + col];
#pragma unroll
            for (int w = 0; w < 8; ++w) s += red[(w * 9 + r) * 64 + col];
            MOD[(size_t)r * NMOD + n0 + col] = s;
        }
        __syncthreads();
    }
}

DI void norm_mod_phase(const float* srcx, const float* srcc, int row0, int nrows, const float* g, const float* mod, int shift_idx, bf16_t* H, int gw, int NGW, int lane) {
    gw += row0;
    f32x4 nx[8];
    if (gw < nrows) { const float* src = gw < MX ? srcx + (size_t)gw * D : srcc + (size_t)(gw - MX) * D; const f32x4* xr = (const f32x4*)src + lane;
#pragma unroll
        for (int j = 0; j < 8; ++j) nx[j] = xr[64 * j]; }
    for (int r = gw; r < nrows; r += NGW) {
        const int mb = r < MX ? (r >> 11) : 8;
        f32x4 v[8]; float ss = 0.f;
#pragma unroll
        for (int j = 0; j < 8; ++j) { v[j] = nx[j]; ss += (v[j].x * v[j].x + v[j].y * v[j].y) + (v[j].z * v[j].z + v[j].w * v[j].w); }
        const int rn = r + NGW;
        if (rn < nrows) { const float* src = rn < MX ? srcx + (size_t)rn * D : srcc + (size_t)(rn - MX) * D; const f32x4* xr = (const f32x4*)src + lane;
#pragma unroll
            for (int j = 0; j < 8; ++j) nx[j] = xr[64 * j]; }
        const float rstd = rsqrtf(wave_sum(ss) * (1.0f / D) + 1e-6f);
        const float* sh = mod + (size_t)mb * NMOD + shift_idx * D; const float* scl = sh + D;
        u32x2* o8 = (u32x2*)(H + (size_t)r * D) + lane;
#pragma unroll
        for (int j = 0; j < 8; ++j) {
            const int c = (lane + 64 * j) * 4;
            const f32x4 gg = *(const f32x4*)(g + c), s1 = *(const f32x4*)(scl + c), s0 = *(const f32x4*)(sh + c);
            const f32x4 y = (v[j] * rstd) * gg * (s1 + 1.0f) + s0;
            u32x2 w; w.x = cvt_pk_bf16(y.x, y.y); w.y = cvt_pk_bf16(y.z, y.w); o8[64 * j] = w;
        }
    }
}
DI void norm_mod_batched(const float* src, const float* g, const float* mod, int shift_idx, bf16_t* H, LAS unsigned char* L, int q, int P, int wid, int lane) {
    const int per = P >> 3, b = q / per, j = q - b * per;
    LAS float* gam = (LAS float*)L; LAS float* shf = gam + 2048;
    { const float* sh = mod + (size_t)b * NMOD + shift_idx * D; const float* scl = sh + D;
      for (int i = threadIdx.x; i < 2048; i += NT) { gam[i] = g[i] * (1.0f + scl[i]); shf[i] = sh[i]; } }
    __syncthreads();
    const int k0 = j + wid * per, kstep = 8 * per;
    f32x4 nx[8];
    if (k0 < 2048) { const f32x4* xr = (const f32x4*)(src + ((size_t)b * 2048 + k0) * D) + lane;
#pragma unroll
        for (int jj = 0; jj < 8; ++jj) nx[jj] = xr[64 * jj]; }
    for (int k = k0; k < 2048; k += kstep) {
        const size_t r = (size_t)b * 2048 + k;
        f32x4 v[8]; float ss = 0.f;
#pragma unroll
        for (int jj = 0; jj < 8; ++jj) { v[jj] = nx[jj]; ss += (v[jj].x * v[jj].x + v[jj].y * v[jj].y) + (v[jj].z * v[jj].z + v[jj].w * v[jj].w); }
        const int kn = k + kstep;
        if (kn < 2048) { const f32x4* xr = (const f32x4*)(src + ((size_t)b * 2048 + kn) * D) + lane;
#pragma unroll
            for (int jj = 0; jj < 8; ++jj) nx[jj] = xr[64 * jj]; }
        const float rstd = rsqrtf(wave_sum(ss) * (1.0f / D) + 1e-6f);
        u32x2* o8 = (u32x2*)(H + r * D) + lane;
#pragma unroll
        for (int jj = 0; jj < 8; ++jj) {
            const int c = (lane + 64 * jj) * 4;
            const f32x4 y = (v[jj] * rstd) * *(const LAS f32x4*)(gam + c) + *(const LAS f32x4*)(shf + c);
            u32x2 w; w.x = cvt_pk_bf16(y.x, y.y); w.y = cvt_pk_bf16(y.z, y.w); o8[64 * jj] = w;
        }
    }
    __syncthreads();
}
DI void ctx_norm_from_partials(const float* ctx, const float* Pa, const float* Pb, const float* g, const float* mod, bf16_t* H, int gw, int NGW, int lane) {
    const float* m8 = mod + (size_t)8 * NMOD;
    for (int r = gw; r < MC; r += NGW) {
        const f32x4* xr = (const f32x4*)(ctx + (size_t)r * D) + lane; const f32x4* pa = (const f32x4*)(Pa + (size_t)r * D) + lane; const f32x4* pb = (const f32x4*)(Pb + (size_t)r * D) + lane;
        f32x4 v[8]; float ss = 0.f;
#pragma unroll
        for (int j = 0; j < 8; ++j) {
            const int c = (lane + 64 * j) * 4;
            const f32x4 gt = *(const f32x4*)(m8 + 2 * D + c) * 0.5f;
            v[j] = xr[64 * j] + gt * (pa[64 * j] + pb[64 * j]);
            ss += (v[j].x * v[j].x + v[j].y * v[j].y) + (v[j].z * v[j].z + v[j].w * v[j].w);
        }
        const float rstd = rsqrtf(wave_sum(ss) * (1.0f / D) + 1e-6f);
        u32x2* o8 = (u32x2*)(H + (size_t)(MX + r) * D) + lane;
#pragma unroll
        for (int j = 0; j < 8; ++j) {
            const int c = (lane + 64 * j) * 4;
            const f32x4 gg = *(const f32x4*)(g + c), s1 = *(const f32x4*)(m8 + 4 * D + c), s0 = *(const f32x4*)(m8 + 3 * D + c);
            const f32x4 y = (v[j] * rstd) * gg * (s1 + 1.0f) + s0;
            u32x2 w; w.x = cvt_pk_bf16(y.x, y.y); w.y = cvt_pk_bf16(y.z, y.w); o8[64 * j] = w;
        }
    }
}
DI void final_norm_phase(float* xo, const float* g, int gw, int NGW, int lane) {
    f32x4 nx[8];
    if (gw < MX) { const f32x4* xr = (const f32x4*)(xo + (size_t)gw * D) + lane;
#pragma unroll
        for (int j = 0; j < 8; ++j) nx[j] = __builtin_nontemporal_load(xr + 64 * j); }
    for (int r = gw; r < MX; r += NGW) {
        f32x4* xw = (f32x4*)(xo + (size_t)r * D) + lane;
        f32x4 v[8]; float ss = 0.f;
#pragma unroll
        for (int j = 0; j < 8; ++j) { v[j] = nx[j]; ss += (v[j].x * v[j].x + v[j].y * v[j].y) + (v[j].z * v[j].z + v[j].w * v[j].w); }
        const int rn = r + NGW;
        if (rn < MX) { const f32x4* xr = (const f32x4*)(xo + (size_t)rn * D) + lane;
#pragma unroll
            for (int j = 0; j < 8; ++j) nx[j] = __builtin_nontemporal_load(xr + 64 * j); }
        const float rstd = rsqrtf(wave_sum(ss) * (1.0f / D) + 1e-6f);
#pragma unroll
        for (int j = 0; j < 8; ++j) { const int c = (lane + 64 * j) * 4; __builtin_nontemporal_store((v[j] * rstd) * *(const f32x4*)(g + c), xw + 64 * j); }
    }
}

constexpr int PL_QN = 0, PL_KN = 17408, PL_KT = 34816, PL_VT = 53248, PL_KK = 71680, PL_QK = 88320, PL_LC1 = 104960, PL_TB = 121344, PL_VEC = 158208;
static_assert(PL_VEC + 1024 <= LDS_BYTES, "prep lds");

DI void dn_prep_item(const Params& p, LAS unsigned char* L, int b, int c, int h) {
    int tid_ = threadIdx.x; asm volatile("" : "+v"(tid_));
    const int tid = tid_, lane = tid & 63, wid = tid >> 6, fr = lane & 15, fq = lane >> 4;
    LAS bf16_t* Qn = (LAS bf16_t*)(L + PL_QN); LAS bf16_t* Kn = (LAS bf16_t*)(L + PL_KN);
    LAS bf16_t* KT = (LAS bf16_t*)(L + PL_KT); LAS bf16_t* VT = (LAS bf16_t*)(L + PL_VT);
    LAS float* KKf = (LAS float*)(L + PL_KK); LAS float* QKf = (LAS float*)(L + PL_QK);
    int base_row, seq_lo, seq_hi;
    if (c < 4) { seq_lo = MX + b * 256; seq_hi = seq_lo + 256; base_row = seq_lo + c * 64; }
    else { seq_lo = b * 2048; seq_hi = seq_lo + 2048; base_row = seq_lo + (c - 4) * 64; }
    const bool is_lat = c >= 4;
    const int dw = __builtin_amdgcn_readfirstlane(wid) & 1;
#define SLOT_OF(dd) ((size_t)(((((b & 3) * 8 + h) * 2 + (dd)) * 36) + ((dd) == 0 ? c : (c < 4 ? 3 - c : 39 - c))))
#define LC_OF(dd) ((LAS float*)(L + ((dd) ? PL_LC1 : PL_KN)))
#define TB_OF(dd) ((LAS bf16_t*)(L + PL_TB + (dd) * 18432))
#define TBG_OF(dd) ((LAS bf16_t*)(L + PL_TB + (dd) * 18432 + 9216))
#define VGC_OF(dd) ((LAS float*)(L + PL_VEC) + (dd) * 128)

    float ab_a = 0.f, ab_b = 0.f;
    if (wid < 2) {
        const int tok = dw ? 63 - lane : lane;
        const float* AB = (const float*)(p.ws + OFF_AB) + (size_t)(base_row + tok) * 32;
        ab_a = AB[dw * 8 + h]; ab_b = AB[16 + dw * 8 + h];
    }
    LAS bf16_t* Zs = (LAS bf16_t*)(L + PL_KK);
    LAS float* Ws = (LAS float*)(L + PL_KK + 53312);
    {
        const bf16_t* Z = (const bf16_t*)(p.ws + OFF_ZQKV);
        u32x4 zr[7]; f32x4 wr4 = (f32x4){0.f, 0.f, 0.f, 0.f};
#pragma unroll
        for (int e = 0; e < 7; ++e) {
            const int idx = tid + NT * e; zr[e] = (u32x4){0u, 0u, 0u, 0u};
            if (idx < 68 * 48) {
                const int row = idx / 48, rem = idx - row * 48, seg = rem >> 4, c16 = rem & 15, rr = base_row - 2 + row;
                if (rr >= seq_lo && rr < seq_hi) zr[e] = *(const u32x4*)(Z + (size_t)rr * 3072 + seg * 1024 + h * 128 + c16 * 8);
            }
        }
        if (tid < 480) { const int j = tid / 96, rem = tid - j * 96, seg = rem >> 5, c4 = rem & 31; wr4 = *(const f32x4*)(p.conv_w + j * 3072 + seg * 1024 + h * 128 + c4 * 4); }
#pragma unroll
        for (int e = 0; e < 7; ++e) {
            const int idx = tid + NT * e;
            if (idx < 68 * 48) { const int row = idx / 48, rem = idx - row * 48, seg = rem >> 4, c16 = rem & 15; *(LAS u32x4*)(Zs + row * 392 + seg * 128 + c16 * 8) = zr[e]; }
        }
        if (tid < 480) { const int j = tid / 96, rem = tid - j * 96, seg = rem >> 5, c4 = rem & 31; *(LAS f32x4*)(Ws + j * 384 + seg * 128 + c4 * 4) = wr4; }
    }
    __syncthreads();
    {
        const int t = tid & 63, sg = tid >> 6;
        LAS float* ssb = (LAS float*)(L + PL_TB + 2 * 18432 - 4096);
        float yq[16], yk[16];
#pragma unroll
        for (int seg = 0; seg < 3; ++seg) {
            float y[16];
#pragma unroll
            for (int hf = 0; hf < 2; ++hf) {
                typedef float f32x2 __attribute__((ext_vector_type(2)));
                f32x2 ap[4];
#pragma unroll
                for (int i = 0; i < 4; ++i) ap[i] = (f32x2){0.f, 0.f};
#pragma unroll
                for (int j = 0; j < 5; ++j) {
                    const u32x4 zz = *(const LAS u32x4*)(Zs + (t + j) * 392 + seg * 128 + sg * 16 + hf * 8);
                    const LAS float* cw = Ws + j * 384 + seg * 128 + sg * 16 + hf * 8;
                    const f32x4 w0 = *(const LAS f32x4*)cw, w1 = *(const LAS f32x4*)(cw + 4);
                    ap[0] += (f32x2){w0.x, w0.y} * (f32x2){bflo(zz.x), bfhi(zz.x)}; ap[1] += (f32x2){w0.z, w0.w} * (f32x2){bflo(zz.y), bfhi(zz.y)};
                    ap[2] += (f32x2){w1.x, w1.y} * (f32x2){bflo(zz.z), bfhi(zz.z)}; ap[3] += (f32x2){w1.z, w1.w} * (f32x2){bflo(zz.w), bfhi(zz.w)};
                }
#pragma unroll
                for (int i = 0; i < 4; ++i) { y[hf * 8 + 2 * i] = silu_f(ap[i].x); y[hf * 8 + 2 * i + 1] = silu_f(ap[i].y); }
            }
            if (seg < 2) {
                float ss = 0.f;
#pragma unroll
                for (int i = 0; i < 16; ++i) ss += y[i] * y[i];
                ssb[(seg * 8 + sg) * 64 + t] = ss;
#pragma unroll
                for (int i = 0; i < 16; ++i) { if (seg == 0) yq[i] = y[i]; else yk[i] = y[i]; }
            } else {
                LAS bf16_t* dstT = VT + (sg * 16) * 72 + t;
#pragma unroll
                for (int i = 0; i < 16; ++i) dstT[i * 72] = (bf16_t)f2bf(y[i]);
            }
        }
        __syncthreads();
        float sq = 0.f, sk = 0.f;
#pragma unroll
        for (int w = 0; w < 8; ++w) { sq += ssb[w * 64 + t]; sk += ssb[(8 + w) * 64 + t]; }
        const float scq = rsqrtf(sq + 1e-6f) * 0.08838834764831845f, sck = rsqrtf(sk + 1e-6f);
#pragma unroll
        for (int i = 0; i < 16; ++i) { yq[i] *= scq; yk[i] *= sck; }
        {
            u32x4 w0, w1;
            w0.x = cvt_pk_bf16(yq[0], yq[1]); w0.y = cvt_pk_bf16(yq[2], yq[3]); w0.z = cvt_pk_bf16(yq[4], yq[5]); w0.w = cvt_pk_bf16(yq[6], yq[7]);
            w1.x = cvt_pk_bf16(yq[8], yq[9]); w1.y = cvt_pk_bf16(yq[10], yq[11]); w1.z = cvt_pk_bf16(yq[12], yq[13]); w1.w = cvt_pk_bf16(yq[14], yq[15]);
            LAS bf16_t* dq = Qn + t * 136 + sg * 16; *(LAS u32x4*)dq = w0; *(LAS u32x4*)(dq + 8) = w1;
            w0.x = cvt_pk_bf16(yk[0], yk[1]); w0.y = cvt_pk_bf16(yk[2], yk[3]); w0.z = cvt_pk_bf16(yk[4], yk[5]); w0.w = cvt_pk_bf16(yk[6], yk[7]);
            w1.x = cvt_pk_bf16(yk[8], yk[9]); w1.y = cvt_pk_bf16(yk[10], yk[11]); w1.z = cvt_pk_bf16(yk[12], yk[13]); w1.w = cvt_pk_bf16(yk[14], yk[15]);
            LAS bf16_t* dk2 = Kn + t * 136 + sg * 16; *(LAS u32x4*)dk2 = w0; *(LAS u32x4*)(dk2 + 8) = w1;
            LAS bf16_t* dstT = KT + (sg * 16) * 72 + t;
#pragma unroll
            for (int i = 0; i < 16; ++i) dstT[i * 72] = (bf16_t)f2bf(yk[i]);
        }
    }
    if (wid < 2) {
        LAS float* vgc = VGC_OF(dw); LAS float* vbeta = vgc + 64;
        const float xx = ab_a + p.dt_bias[dw * 8 + h];
        const float sp = xx > 20.f ? xx : log1pf(expf(xx));
        float gcv = -expf(p.a_log[dw * 8 + h]) * sp;
#pragma unroll
        for (int o = 1; o < 64; o <<= 1) { const float t = __shfl_up(gcv, o); if (lane >= o) gcv += t; }
        vgc[lane] = gcv; vbeta[lane] = 1.0f / (1.0f + expf(-ab_b));
    }
    __syncthreads();
    {
        const LAS bf16_t* Am = (wid >> 2) ? Qn : Kn; LAS float* Mo = (wid >> 2) ? QKf : KKf; const int ti = wid & 3;
        bf16x8 af[4];
#pragma unroll
        for (int k = 0; k < 4; ++k) af[k] = *(const LAS bf16x8*)(Am + (ti * 16 + fr) * 136 + k * 32 + fq * 8);
#pragma unroll
        for (int tj = 0; tj < 4; ++tj) {
            f32x4 acc = (f32x4){0.f, 0.f, 0.f, 0.f};
#pragma unroll
            for (int k = 0; k < 4; ++k) acc = MFMA16(af[k], *(const LAS bf16x8*)(Kn + (tj * 16 + fr) * 136 + k * 32 + fq * 8), acc);
#pragma unroll
            for (int j = 0; j < 4; ++j) Mo[(ti * 16 + fq * 4 + j) * 65 + tj * 16 + fr] = acc[j];
        }
    }
    __syncthreads();
#pragma unroll
    for (int dd = 0; dd < 2; ++dd) {
        const LAS float* vgc = VGC_OF(dd); const LAS float* vbeta = vgc + 64; LAS float* Lc = LC_OF(dd);
#pragma unroll
        for (int e = 0; e < 8; ++e) {
            const int idx = tid + NT * e, j = idx >> 6, i = idx & 63;
            const int ti = dd ? 63 - i : i, tj = dd ? 63 - j : j;
            Lc[idx] = (i > j) ? vbeta[i] * KKf[ti * 65 + tj] * __expf(vgc[i] - vgc[j]) : 0.f;
        }
    }
    __syncthreads();
    LAS bf16_t* XI = (LAS bf16_t*)(L + PL_KK);
#define AINVT_OF(dd) (XI + (dd) * 3840)
#define BINVR_OF(dd) (XI + (dd) * 3840 + 1280)
#define CR_OF(dd) (XI + (dd) * 3840 + 2560)
    if (wid < 4) {
        const int dd = __builtin_amdgcn_readfirstlane(wid) >> 1, blk = __builtin_amdgcn_readfirstlane(wid) & 1, o = blk * 32;
        const LAS float* vgc = VGC_OF(dd); const LAS float* vbeta = vgc + 64;
        LAS bf16_t* TB = TB_OF(dd); LAS bf16_t* TBG = TBG_OF(dd);
        unsigned lcb = (unsigned)(size_t)(LC_OF(dd) + o * 64 + o); asm volatile("" : "+v"(lcb));
        const LAS float* Lcv = (const LAS float*)lcb;
        typedef float f32x2 __attribute__((ext_vector_type(2)));
        const int c = lane & 31, hh = lane >> 5;
        f32x2 x2[16];
#pragma unroll
        for (int m = 0; m < 16; ++m) x2[m] = (f32x2){(2 * m == c) ? 1.f : 0.f, (2 * m + 1 == c) ? 1.f : 0.f};
        float xprev = 0.f;
#pragma unroll
        for (int j = 0; j < 31; ++j) {
            const float xj = (j & 1) ? x2[j >> 1].y : x2[j >> 1].x; const f32x2 xjj = (f32x2){xj, xj};
            unsigned bj = lcb; asm volatile("" : "+v"(bj) : "v"(j ? xprev : xj)); const LAS float* Lj = (const LAS float*)bj; (void)Lcv;
            xprev = xj;
#pragma unroll
            for (int i4 = ((j + 1) & ~3); i4 < 32; i4 += 4) {
                const f32x4 l = *(const LAS f32x4*)(Lj + j * 64 + i4);
                x2[i4 >> 1] -= (f32x2){l.x, l.y} * xjj; x2[(i4 >> 1) + 1] -= (f32x2){l.z, l.w} * xjj;
            }
        }
        const int cdir = o + c, tc = dd ? 63 - cdir : cdir;
        const float bc = vbeta[cdir], bg = bc * __expf(vgc[cdir]);
        if (hh == 0) {
#pragma unroll
            for (int m = 0; m < 16; ++m) {
                TB[(o + 2 * m) * 72 + tc] = (bf16_t)f2bf(x2[m].x * bc); TBG[(o + 2 * m) * 72 + tc] = (bf16_t)f2bf(x2[m].x * bg);
                TB[(o + 2 * m + 1) * 72 + tc] = (bf16_t)f2bf(x2[m].y * bc); TBG[(o + 2 * m + 1) * 72 + tc] = (bf16_t)f2bf(x2[m].y * bg);
            }
            if (blk == 0) {
                LAS bf16_t* ai = AINVT_OF(dd) + c * 40;
#pragma unroll
                for (int q = 0; q < 4; ++q) { u32x4 w; w.x = cvt_pk_bf16(x2[4 * q].x, x2[4 * q].y); w.y = cvt_pk_bf16(x2[4 * q + 1].x, x2[4 * q + 1].y); w.z = cvt_pk_bf16(x2[4 * q + 2].x, x2[4 * q + 2].y); w.w = cvt_pk_bf16(x2[4 * q + 3].x, x2[4 * q + 3].y); *(LAS u32x4*)(ai + 8 * q) = w; }
            } else {
                LAS bf16_t* bi = BINVR_OF(dd) + c;
#pragma unroll
                for (int m = 0; m < 16; ++m) { bi[(2 * m) * 40] = (bf16_t)f2bf(x2[m].x); bi[(2 * m + 1) * 40] = (bf16_t)f2bf(x2[m].y); }
            }
        } else if (blk == 0) {
            const int cz = 32 + c, tz = dd ? 63 - cz : cz;
#pragma unroll
            for (int i = 0; i < 32; ++i) { TB[i * 72 + tz] = (bf16_t)0; TBG[i * 72 + tz] = (bf16_t)0; }
        }
    } else {
        const int t2 = tid - 256;
#pragma unroll
        for (int dd = 0; dd < 2; ++dd) {
            const LAS float* Lc = LC_OF(dd); LAS bf16_t* cr = CR_OF(dd);
#pragma unroll
            for (int e = 0; e < 4; ++e) { const int idx = t2 + 256 * e, k = idx >> 5, i = idx & 31; cr[i * 40 + k] = (bf16_t)f2bf(Lc[k * 64 + 32 + i]); }
        }
#pragma unroll
        for (int dd = 0; dd < 2; ++dd) {
            const LAS float* vgc = VGC_OF(dd); const float gl = vgc[63];
            unsigned char* item = p.ws + OFF_PREP + SLOT_OF(dd) * PREP_STRIDE;
            if (is_lat) {
                unsigned* oqk = (unsigned*)(item + PI_QK);
                for (int idx = t2; idx < 2048; idx += 256) {
                    const int i = idx >> 5, j0 = (idx & 31) * 2, ti = dd ? 63 - i : i;
                    const int tj0 = dd ? 63 - j0 : j0, tj1 = dd ? 62 - j0 : j0 + 1;
                    const float v0 = (i >= j0) ? QKf[ti * 65 + tj0] * __expf(vgc[i] - vgc[j0]) : 0.f;
                    const float v1 = (i >= j0 + 1) ? QKf[ti * 65 + tj1] * __expf(vgc[i] - vgc[j0 + 1]) : 0.f;
                    oqk[idx] = cvt_pk_bf16(v0, v1);
                }
                u32x4* oqd = (u32x4*)(item + PI_QD);
                for (int idx = t2; idx < 1024; idx += 256) {
                    const int i = idx >> 4, c8 = idx & 15, ti = dd ? 63 - i : i; const float eg = __expf(vgc[i]);
                    const u32x4 q = *(const LAS u32x4*)(Qn + ti * 136 + c8 * 8); u32x4 o;
                    o.x = cvt_pk_bf16(bflo(q.x) * eg, bfhi(q.x) * eg); o.y = cvt_pk_bf16(bflo(q.y) * eg, bfhi(q.y) * eg);
                    o.z = cvt_pk_bf16(bflo(q.z) * eg, bfhi(q.z) * eg); o.w = cvt_pk_bf16(bflo(q.w) * eg, bfhi(q.w) * eg);
                    oqd[idx] = o;
                }
            }
            u32x4* okd = (u32x4*)(item + PI_KDT);
            for (int idx = t2; idx < 1024; idx += 256) {
                const int dk = idx >> 3, j8 = idx & 7, tmin = dd ? 56 - j8 * 8 : j8 * 8;
                const u32x4 kq = *(const LAS u32x4*)(KT + dk * 72 + tmin);
                float e[8] = {bflo(kq.x), bfhi(kq.x), bflo(kq.y), bfhi(kq.y), bflo(kq.z), bfhi(kq.z), bflo(kq.w), bfhi(kq.w)};
                float r[8];
#pragma unroll
                for (int jj = 0; jj < 8; ++jj) r[jj] = (dd ? e[7 - jj] : e[jj]) * __expf(gl - vgc[j8 * 8 + jj]);
                u32x4 o; o.x = cvt_pk_bf16(r[0], r[1]); o.y = cvt_pk_bf16(r[2], r[3]); o.z = cvt_pk_bf16(r[4], r[5]); o.w = cvt_pk_bf16(r[6], r[7]);
                okd[idx] = o;
            }
            if (t2 == 0) *(float*)(item + PI_GL) = __expf(gl);
        }
    }
    __syncthreads();
    if (wid == 0 || wid == 2) {
        typedef float f32x16 __attribute__((ext_vector_type(16)));
        const int dd = __builtin_amdgcn_readfirstlane(wid) >> 1, r = lane & 31, hh = lane >> 5;
        const LAS float* vgc = VGC_OF(dd); const LAS float* vbeta = vgc + 64;
        LAS bf16_t* TB = TB_OF(dd); LAS bf16_t* TBG = TBG_OF(dd);
        f32x16 Y, M;
#pragma unroll
        for (int x = 0; x < 16; ++x) { Y[x] = 0.f; M[x] = 0.f; }
#pragma unroll
        for (int sx = 0; sx < 2; ++sx)
            Y = __builtin_amdgcn_mfma_f32_32x32x16_bf16(*(const LAS bf16x8*)(CR_OF(dd) + r * 40 + 16 * sx + 8 * hh), *(const LAS bf16x8*)(AINVT_OF(dd) + r * 40 + 16 * sx + 8 * hh), Y, 0, 0, 0);
#pragma unroll
        for (int sx = 0; sx < 2; ++sx) {
            u32x4 yb; yb.x = cvt_pk_bf16(Y[8 * sx], Y[8 * sx + 1]); yb.y = cvt_pk_bf16(Y[8 * sx + 2], Y[8 * sx + 3]); yb.z = cvt_pk_bf16(Y[8 * sx + 4], Y[8 * sx + 5]); yb.w = cvt_pk_bf16(Y[8 * sx + 6], Y[8 * sx + 7]);
            const u32x2 lo = *(const LAS u32x2*)(BINVR_OF(dd) + r * 40 + 16 * sx + 4 * hh), hi = *(const LAS u32x2*)(BINVR_OF(dd) + r * 40 + 16 * sx + 8 + 4 * hh);
            u32x4 pa; pa.x = lo.x; pa.y = lo.y; pa.z = hi.x; pa.w = hi.y;
            M = __builtin_amdgcn_mfma_f32_32x32x16_bf16(__builtin_bit_cast(bf16x8, pa), __builtin_bit_cast(bf16x8, yb), M, 0, 0, 0);
        }
        const int tc = dd ? 63 - r : r; const float bc = vbeta[r], bg = bc * __expf(vgc[r]);
#pragma unroll
        for (int x = 0; x < 16; ++x) {
            const int i = 32 + (x & 3) + 8 * (x >> 2) + 4 * hh;
            TB[i * 72 + tc] = (bf16_t)f2bf(-M[x] * bc); TBG[i * 72 + tc] = (bf16_t)f2bf(-M[x] * bg);
        }
    }
    __syncthreads();
#undef AINVT_OF
#undef BINVR_OF
#undef CR_OF
    {
        const int dd = __builtin_amdgcn_readfirstlane(wid) >> 2, mat = (wid >> 1) & 1;
        const LAS bf16_t* Am = mat ? TBG_OF(dd) : TB_OF(dd); const LAS bf16_t* Bm = mat ? KT : VT;
        LAS bf16_t* img = (LAS bf16_t*)(L + (dd ? PL_KK : PL_QN) + mat * 17408); const float sgn = mat ? -1.f : 1.f;
#pragma unroll
        for (int th = 0; th < 2; ++th) {
            const int ti = (wid & 1) * 2 + th;
            const bf16x8 a0 = *(const LAS bf16x8*)(Am + (ti * 16 + fr) * 72 + fq * 8), a1 = *(const LAS bf16x8*)(Am + (ti * 16 + fr) * 72 + 32 + fq * 8);
#pragma unroll
            for (int tn = 0; tn < 8; ++tn) {
                f32x4 acc = (f32x4){0.f, 0.f, 0.f, 0.f};
                acc = MFMA16(a0, *(const LAS bf16x8*)(Bm + (tn * 16 + fr) * 72 + fq * 8), acc);
                acc = MFMA16(a1, *(const LAS bf16x8*)(Bm + (tn * 16 + fr) * 72 + 32 + fq * 8), acc);
#pragma unroll
                for (int j = 0; j < 4; ++j) img[(ti * 16 + fq * 4 + j) * 136 + tn * 16 + fr] = (bf16_t)f2bf(acc[j] * sgn);
            }
        }
    }
    __syncthreads();
#pragma unroll
    for (int e = 0; e < 8; ++e) {
        const int idx = tid + NT * e, dd = idx >> 11, mat = (idx >> 10) & 1, row = (idx >> 4) & 63, cq = idx & 15;
        const u32x4 v = *(const LAS u32x4*)((const LAS bf16_t*)(L + (dd ? PL_KK : PL_QN) + mat * 17408) + row * 136 + cq * 8);
        *(u32x4*)(p.ws + OFF_PREP + SLOT_OF(dd) * PREP_STRIDE + (mat ? PI_W : PI_U) + row * 256 + cq * 16) = v;
    }
    __syncthreads();
#undef SLOT_OF
#undef LC_OF
#undef TB_OF
#undef TBG_OF
#undef VGC_OF
}

DI void chunk_mlp_item(const Params& p, LAS unsigned char* L, int b, int n, int g) {
    int tid_ = threadIdx.x; asm volatile("" : "+v"(tid_));
    const int tid = tid_, lane = tid & 63, wid = tid >> 6, fr = lane & 15, fq = lane >> 4;
    LAS bf16_t* SW = (LAS bf16_t*)L; LAS bf16_t* VNT = (LAS bf16_t*)(L + 34816);
    const int row0 = b * 2048 + n * 128;
    {
        const int pr = tid >> 2, part = tid & 3;
        const float* sw = p.spatial_w + ((size_t)g * 128 + pr) * 128 + part * 32;
#pragma unroll
        for (int i = 0; i < 4; ++i) {
            const f32x4 a = *(const f32x4*)(sw + i * 8), c = *(const f32x4*)(sw + i * 8 + 4);
            u32x4 w; w.x = cvt_pk_bf16(a.x, a.y); w.y = cvt_pk_bf16(a.z, a.w); w.z = cvt_pk_bf16(c.x, c.y); w.w = cvt_pk_bf16(c.z, c.w);
            *(LAS u32x4*)(SW + pr * 136 + part * 32 + i * 8) = w;
        }
        const bf16_t* zv = (const bf16_t*)(p.ws + OFF_ZV) + (size_t)(row0 + pr) * 1024 + g * 128 + part * 32;
        float v[32]; float ss = 0.f;
#pragma unroll
        for (int i = 0; i < 4; ++i) {
            const u32x4 q = *(const u32x4*)(zv + i * 8);
            v[i * 8 + 0] = bflo(q.x); v[i * 8 + 1] = bfhi(q.x); v[i * 8 + 2] = bflo(q.y); v[i * 8 + 3] = bfhi(q.y);
            v[i * 8 + 4] = bflo(q.z); v[i * 8 + 5] = bfhi(q.z); v[i * 8 + 6] = bflo(q.w); v[i * 8 + 7] = bfhi(q.w);
        }
#pragma unroll
        for (int i = 0; i < 32; ++i) ss += v[i] * v[i];
        ss += __shfl_xor(ss, 1); ss += __shfl_xor(ss, 2);
        const float rstd = rsqrtf(ss * (1.0f / 128.0f) + 1e-6f);
        const float* vg = p.mlp_norm_g + g * 128 + part * 32;
#pragma unroll
        for (int i = 0; i < 32; ++i) VNT[(part * 32 + i) * 136 + pr] = (bf16_t)f2bf(v[i] * rstd * vg[i]);
    }
    __syncthreads();
    f32x4 acc[8];
#pragma unroll
    for (int ci = 0; ci < 8; ++ci) acc[ci] = (f32x4){0.f, 0.f, 0.f, 0.f};
#pragma unroll
    for (int k = 0; k < 4; ++k) {
        const bf16x8 a = *(const LAS bf16x8*)(SW + (wid * 16 + fr) * 136 + k * 32 + fq * 8);
#pragma unroll
        for (int ci = 0; ci < 8; ++ci) acc[ci] = MFMA16(a, *(const LAS bf16x8*)(VNT + (ci * 16 + fr) * 136 + k * 32 + fq * 8), acc[ci]);
    }
    LAS float* Sf = (LAS float*)(L + 69632);
#pragma unroll
    for (int j = 0; j < 4; ++j) {
        const int pp = wid * 16 + fq * 4 + j; const float bs = p.spatial_b[g * 128 + pp];
#pragma unroll
        for (int ci = 0; ci < 8; ++ci) Sf[pp * 132 + ci * 16 + fr] = acc[ci][j] + bs;
    }
    __syncthreads();
    const bf16_t* ZU = (const bf16_t*)(p.ws + OFF_ZU); bf16_t* O = (bf16_t*)(p.ws + OFF_O);
#pragma unroll
    for (int e = 0; e < 4; ++e) {
        const int idx = tid + NT * e, pp = idx >> 4, c8 = idx & 15; const size_t row = row0 + pp;
        const u32x4 zu = *(const u32x4*)(ZU + row * 1024 + g * 128 + c8 * 8);
        const f32x4 s0 = *(const LAS f32x4*)(Sf + pp * 132 + c8 * 8), s1 = *(const LAS f32x4*)(Sf + pp * 132 + c8 * 8 + 4);
        u32x4 o; o.x = cvt_pk_bf16(bflo(zu.x) * s0.x, bfhi(zu.x) * s0.y); o.y = cvt_pk_bf16(bflo(zu.y) * s0.z, bfhi(zu.y) * s0.w);
        o.z = cvt_pk_bf16(bflo(zu.z) * s1.x, bfhi(zu.z) * s1.y); o.w = cvt_pk_bf16(bflo(zu.w) * s1.z, bfhi(zu.w) * s1.w);
        *(u32x4*)(O + row * D + 1024 + g * 128 + c8 * 8) = o;
    }
    __syncthreads();
}

constexpr int SL_W = 0, SL_QD = 17408, SL_KDT = 34816, SL_QK = 53248, SL_ST = 62464, SL_VN = 71168;
DI void dn_scan(const Params& p, LAS unsigned char* L, int ch, int round) {
    int tid_ = threadIdx.x; asm volatile("" : "+v"(tid_));
    const int tid = tid_, lane = tid & 63, wid = tid >> 6, fr = lane & 15, fq = lane >> 4;
    const int eq = ch & 3, d = (ch >> 2) & 1, h = (ch >> 3) & 7, bl = ch >> 6, b = round * 4 + bl;
    LAS bf16_t* Wl = (LAS bf16_t*)(L + SL_W); LAS bf16_t* QDl = (LAS bf16_t*)(L + SL_QD); LAS bf16_t* KDTl = (LAS bf16_t*)(L + SL_KDT);
    LAS bf16_t* QKl = (LAS bf16_t*)(L + SL_QK); LAS bf16_t* STl = (LAS bf16_t*)(L + SL_ST); LAS bf16_t* VNl = (LAS bf16_t*)(L + SL_VN);
    f32x4 S[2];
#pragma unroll
    for (int n2 = 0; n2 < 2; ++n2) S[n2] = (f32x4){0.f, 0.f, 0.f, 0.f};
    const int mi = wid >> 1, ni = wid & 1;
    const unsigned char* item0 = p.ws + OFF_PREP + (size_t)((((bl * 8 + h) * 2 + d) * 36)) * PREP_STRIDE;
    u32x4 rW[2][2], rQD[2][2], rKD[2][2], rQK[2]; bf16_t nU[4]; float nGL;
    int vz = 0; asm volatile("" : "+v"(vz));
#define SCAN_LOAD(P, it) do { const unsigned char* _p = (it); \
        rW[P][0] = *(const u32x4*)(_p + PI_W + tid * 16); rW[P][1] = *(const u32x4*)(_p + PI_W + (tid + NT) * 16); \
        rQD[P][0] = *(const u32x4*)(_p + PI_QD + tid * 16); rQD[P][1] = *(const u32x4*)(_p + PI_QD + (tid + NT) * 16); \
        rKD[P][0] = *(const u32x4*)(_p + PI_KDT + tid * 16); rKD[P][1] = *(const u32x4*)(_p + PI_KDT + (tid + NT) * 16); \
        rQK[P] = *(const u32x4*)(_p + PI_QK + tid * 16); } while (0)
#define SCAN_LOADU(it) do { const unsigned char* _p = (it); nGL = *(const float*)(_p + PI_GL + vz); \
        _Pragma("unroll") for (int _j = 0; _j < 4; ++_j) \
            nU[_j] = ((const bf16_t*)(_p + PI_U))[(mi * 16 + fq * 4 + _j) * 128 + eq * 32 + ni * 16 + fr]; } while (0)
#define SCAN_STORE_A(P) do { \
        _Pragma("unroll") for (int _i = 0; _i < 2; ++_i) { const int _x = tid + _i * NT; \
            *(LAS u32x4*)(Wl + (_x >> 4) * 136 + (_x & 15) * 8) = rW[P][_i]; *(LAS u32x4*)(QDl + (_x >> 4) * 136 + (_x & 15) * 8) = rQD[P][_i]; } } while (0)
#define SCAN_STORE_B(P) do { \
        _Pragma("unroll") for (int _i = 0; _i < 2; ++_i) { const int _x = tid + _i * NT; \
            *(LAS u32x4*)(KDTl + (_x >> 3) * 72 + (_x & 7) * 8) = rKD[P][_i]; } \
        *(LAS u32x4*)(QKl + (tid >> 3) * 72 + (tid & 7) * 8) = rQK[P]; } while (0)
    SCAN_LOADU(item0);
    SCAN_LOAD(0, item0);
    SCAN_LOAD(1, item0 + PREP_STRIDE);
#pragma unroll
    for (int n2 = 0; n2 < 2; ++n2) { u32x2 w; w.x = cvt_pk_bf16(S[n2][0], S[n2][1]); w.y = cvt_pk_bf16(S[n2][2], S[n2][3]); *(LAS u32x2*)(STl + (n2 * 16 + fr) * 136 + wid * 16 + fq * 4) = w; }
    SCAN_STORE_A(0); SCAN_STORE_B(0);
    __syncthreads();
    for (int s2 = 0; s2 < NSTEP; s2 += 2) {
#pragma unroll
      for (int par = 0; par < 2; ++par) {
        const int s = s2 + par;
        f32x4 vacc = (f32x4){bf2f(nU[0]), bf2f(nU[1]), bf2f(nU[2]), bf2f(nU[3])}; const float gl = nGL;
        if (s + 1 < NSTEP) SCAN_LOADU(item0 + (size_t)(s + 1) * PREP_STRIDE);
        if (s + 2 < NSTEP) SCAN_LOAD(par, item0 + (size_t)(s + 2) * PREP_STRIDE);
        f32x4 oacc = (f32x4){0.f, 0.f, 0.f, 0.f};
#pragma unroll
        for (int k = 0; k < 4; ++k) {
            const bf16x8 sb = *(const LAS bf16x8*)(STl + (ni * 16 + fr) * 136 + k * 32 + fq * 8);
            vacc = MFMA16(*(const LAS bf16x8*)(Wl + (mi * 16 + fr) * 136 + k * 32 + fq * 8), sb, vacc);
            if (s >= 4) oacc = MFMA16(*(const LAS bf16x8*)(QDl + (mi * 16 + fr) * 136 + k * 32 + fq * 8), sb, oacc);
        }
        { u32x2 w; w.x = cvt_pk_bf16(vacc[0], vacc[1]); w.y = cvt_pk_bf16(vacc[2], vacc[3]); *(LAS u32x2*)(VNl + (ni * 16 + fr) * 72 + mi * 16 + fq * 4) = w; }
        __syncthreads();
        if (s >= 4) {
#pragma unroll
            for (int k = 0; k < 2; ++k)
                oacc = MFMA16(*(const LAS bf16x8*)(QKl + (mi * 16 + fr) * 72 + k * 32 + fq * 8), *(const LAS bf16x8*)(VNl + (ni * 16 + fr) * 72 + k * 32 + fq * 8), oacc);
            const int lc = d ? 31 - (s - 4) : (s - 4);
            bf16_t* od = (bf16_t*)(p.ws + OFF_ODIR) + (size_t)d * MX * 1024;
#pragma unroll
            for (int j = 0; j < 4; ++j) {
                const int i = mi * 16 + fq * 4 + j, tok = d ? 63 - i : i; const size_t row = (size_t)b * 2048 + lc * 64 + tok;
                od[row * 1024 + h * 128 + eq * 32 + ni * 16 + fr] = (bf16_t)f2bf(oacc[j]);
            }
        }
#pragma unroll
        for (int n2 = 0; n2 < 2; ++n2) S[n2] *= gl;
#pragma unroll
        for (int k = 0; k < 2; ++k) {
            const bf16x8 a = *(const LAS bf16x8*)(KDTl + (wid * 16 + fr) * 72 + k * 32 + fq * 8);
#pragma unroll
            for (int n2 = 0; n2 < 2; ++n2) S[n2] = MFMA16(a, *(const LAS bf16x8*)(VNl + (n2 * 16 + fr) * 72 + k * 32 + fq * 8), S[n2]);
        }
#pragma unroll
        for (int n2 = 0; n2 < 2; ++n2) { u32x2 w; w.x = cvt_pk_bf16(S[n2][0], S[n2][1]); w.y = cvt_pk_bf16(S[n2][2], S[n2][3]); *(LAS u32x2*)(STl + (n2 * 16 + fr) * 136 + wid * 16 + fq * 4) = w; }
        if (s + 1 < NSTEP) SCAN_STORE_A(par ^ 1);
        __syncthreads();
        if (s + 1 < NSTEP) SCAN_STORE_B(par ^ 1);
      }
    }
#undef SCAN_LOAD
#undef SCAN_LOADU
#undef SCAN_STORE_A
#undef SCAN_STORE_B
}

DI void combine_phase(const Params& p, int gw, int NGW, int lane) {
    const bf16_t* o0 = (const bf16_t*)(p.ws + OFF_ODIR); const bf16_t* o1 = o0 + (size_t)MX * 1024;
    const bf16_t* zg = (const bf16_t*)(p.ws + OFF_ZG); bf16_t* O = (bf16_t*)(p.ws + OFF_O);
    for (int r = gw; r < MX; r += NGW) {
        const size_t off = (size_t)r * 1024 + lane * 16;
        float v[16], gt[16]; float ss = 0.f;
#pragma unroll
        for (int i = 0; i < 2; ++i) {
            const u32x4 a = *(const u32x4*)(o0 + off + i * 8), c = *(const u32x4*)(o1 + off + i * 8), g = *(const u32x4*)(zg + off + i * 8);
            v[i * 8 + 0] = bflo(a.x) + bflo(c.x); v[i * 8 + 1] = bfhi(a.x) + bfhi(c.x); v[i * 8 + 2] = bflo(a.y) + bflo(c.y); v[i * 8 + 3] = bfhi(a.y) + bfhi(c.y);
            v[i * 8 + 4] = bflo(a.z) + bflo(c.z); v[i * 8 + 5] = bfhi(a.z) + bfhi(c.z); v[i * 8 + 6] = bflo(a.w) + bflo(c.w); v[i * 8 + 7] = bfhi(a.w) + bfhi(c.w);
            gt[i * 8 + 0] = bflo(g.x); gt[i * 8 + 1] = bfhi(g.x); gt[i * 8 + 2] = bflo(g.y); gt[i * 8 + 3] = bfhi(g.y);
            gt[i * 8 + 4] = bflo(g.z); gt[i * 8 + 5] = bfhi(g.z); gt[i * 8 + 6] = bflo(g.w); gt[i * 8 + 7] = bfhi(g.w);
        }
#pragma unroll
        for (int i = 0; i < 16; ++i) ss += v[i] * v[i];
        ss += __shfl_xor(ss, 1); ss += __shfl_xor(ss, 2); ss += __shfl_xor(ss, 4);
        const float rstd = rsqrtf(ss * (1.0f / 128.0f) + 1e-6f);
        const float* hg = p.head_norm_g + (lane & 7) * 16;
        float y[16];
#pragma unroll
        for (int i = 0; i < 16; ++i) y[i] = v[i] * rstd * hg[i] * gt[i];
        u32x4 w0, w1;
        w0.x = cvt_pk_bf16(y[0], y[1]); w0.y = cvt_pk_bf16(y[2], y[3]); w0.z = cvt_pk_bf16(y[4], y[5]); w0.w = cvt_pk_bf16(y[6], y[7]);
        w1.x = cvt_pk_bf16(y[8], y[9]); w1.y = cvt_pk_bf16(y[10], y[11]); w1.z = cvt_pk_bf16(y[12], y[13]); w1.w = cvt_pk_bf16(y[14], y[15]);
        bf16_t* op = O + (size_t)r * D + lane * 16;
        *(u32x4*)op = w0; *(u32x4*)(op + 8) = w1;
    }
}

#define XB_TMO      128
#define XB_XCNT(j)  (256  + 64 * (j))
#define XB_XSUB(j)  (1280 + 64 * (j))
#define XB_XGEN(j)  (2304 + 64 * (j))
#define XB_TOP      3328
#define XB_TOPGEN   3392
#define XCD_BAR_WORDS 3456
#define XB_SPIN_CAP (1u << 18)

__device__ __forceinline__ unsigned xb_ld(unsigned* p)              { return __hip_atomic_load(p, __ATOMIC_RELAXED, __HIP_MEMORY_SCOPE_AGENT); }
__device__ __forceinline__ unsigned xb_add(unsigned* p, unsigned v) { return __hip_atomic_fetch_add(p, v, __ATOMIC_RELAXED, __HIP_MEMORY_SCOPE_AGENT); }
__device__ __forceinline__ unsigned xb_xcc_id() { return (unsigned)__builtin_amdgcn_s_getreg((3 << 11) | 20) & 0xFu; }
#define XB_SPIN(cond, bar) do { unsigned _sp = 0; while (cond) { __builtin_amdgcn_s_sleep(1); \
    if ((++_sp & 255u) == 0u) { if (xb_ld(&(bar)[XB_TMO])) break; if (_sp > XB_SPIN_CAP) { atomicAdd(&(bar)[XB_TMO], 1u); break; } } } } while (0)

struct XcdBarrier {
    unsigned* bar; unsigned x;
    volatile LAS unsigned* st;
};

__device__ __forceinline__ XcdBarrier xcd_barrier_post(unsigned* bar, volatile LAS unsigned* st) {
    XcdBarrier b; b.bar = bar; b.x = xb_xcc_id(); b.st = st;
    if (threadIdx.x == 0) (void)xb_add(&bar[XB_XCNT(b.x)], 1u);
    return b;
}
__device__ __forceinline__ void xcd_barrier_complete(unsigned* bar, unsigned x, unsigned& nloc, unsigned& nx) {
    const unsigned G = gridDim.x * gridDim.y * gridDim.z;
    unsigned sum, cnt, mine, sp = 0u;
    for (;;) {
        sum = 0u; cnt = 0u; mine = 0u;
#pragma unroll
        for (unsigned j = 0; j < 16; ++j) { const unsigned c = xb_ld(&bar[XB_XCNT(j)]); sum += c; cnt += (c > 0u) ? 1u : 0u; mine = (j == x) ? c : mine; }
        if (sum == G) break;
        __builtin_amdgcn_s_sleep(1);
        if ((++sp & 255u) == 0u) { if (xb_ld(&bar[XB_TMO])) break; if (sp > XB_SPIN_CAP) { atomicAdd(&bar[XB_TMO], 1u); break; } }
    }
    nloc = mine > 0u ? mine : 1u; nx = cnt > 0u ? cnt : 1u;
}

__device__ __forceinline__ void xcd_barrier(const XcdBarrier& b) {
    asm volatile("s_waitcnt vmcnt(0)" ::: "memory");
    __syncthreads();
    if (threadIdx.x == 0) {
        unsigned* bar = b.bar;
        __builtin_amdgcn_s_waitcnt(0);
        unsigned nloc = b.st[0], nx = b.st[1];
        if (nloc == 0u) { xcd_barrier_complete(bar, b.x, nloc, nx); b.st[0] = nloc; b.st[1] = nx; }
        const unsigned old = xb_add(&bar[XB_XSUB(b.x)], 1u);
        const unsigned gen = old / nloc;
        if (old + 1u == (gen + 1u) * nloc) {
            __builtin_amdgcn_fence(__ATOMIC_RELEASE, "agent");
            asm volatile("s_waitcnt vmcnt(0)" ::: "memory");
            const unsigned og = xb_add(&bar[XB_TOP], 1u);
            const unsigned tg = og / nx;
            if (og + 1u == (tg + 1u) * nx) xb_add(&bar[XB_TOPGEN], 1u);
            else XB_SPIN(xb_ld(&bar[XB_TOPGEN]) == tg, bar);
            __builtin_amdgcn_fence(__ATOMIC_ACQUIRE, "agent");
            xb_add(&bar[XB_XGEN(b.x)], 1u);
            asm volatile("s_waitcnt vmcnt(0)" ::: "memory");
        } else {
            XB_SPIN(xb_ld(&bar[XB_XGEN(b.x)]) == gen, bar);
            __builtin_amdgcn_fence(__ATOMIC_ACQUIRE, "agent");
            asm volatile("s_waitcnt vmcnt(0)" ::: "memory");
        }
    }
    __syncthreads();
}

DI void fast_gsync(unsigned* bar, unsigned target) {
    asm volatile("s_waitcnt vmcnt(0)" ::: "memory");
    __syncthreads();
    if (threadIdx.x == 0) {
        __builtin_amdgcn_fence(__ATOMIC_RELEASE, "agent");
        asm volatile("s_waitcnt vmcnt(0)" ::: "memory");
        __hip_atomic_fetch_add(bar, 1u, __ATOMIC_RELAXED, __HIP_MEMORY_SCOPE_AGENT);
        while (__hip_atomic_load(bar, __ATOMIC_RELAXED, __HIP_MEMORY_SCOPE_AGENT) < target) __builtin_amdgcn_s_sleep(1);
        __builtin_amdgcn_fence(__ATOMIC_ACQUIRE, "agent");
        asm volatile("s_waitcnt vmcnt(0)" ::: "memory");
    }
    __syncthreads();
}
template <class Epi> DI void run_gemm(LAS unsigned char* L, const bf16_t* A, const bf16_t* Bt, int M, int N, int K, const Epi& E) {
    pg8::Gemm g{A, Bt, M, N, K}; pg8::StaticOrder S; S.init(M, N, (int)gridDim.x, (int)blockIdx.x);
    pg8::gemm_phase<Epi, pg8::StaticOrder, false>(L, g, S, E, nullptr);
    __syncthreads();
}

struct InprojOrder {
    int G, c;
    DI bool next(int i, Unit& u) const {
        const int Lx = i * G + c; if (Lx >= 1704) return false;
        if (Lx < 1600) { const int wgid = (Lx % 8) * 200 + Lx / 8; const int gid = wgid / 200, rem = wgid % 200; u.pm = gid * 8 + (rem % 8); u.pn = rem / 8; }
        else { const int l2 = Lx - 1600, q = l2 % 13; u.pm = 64 + l2 / 13; u.pn = q < 12 ? q : 24; }
        return true;
    }
    DI void a_ready(const Unit&) const {}
    DI void done(const Unit&) const {}
};
__global__ void __launch_bounds__(NT, 2) fwd_megakernel(Params p_unused) {
    extern __shared__ __attribute__((aligned(16))) unsigned char lds_raw[];
    LAS unsigned char* L = (LAS unsigned char*)lds_raw;
    cg::grid_group grid = cg::this_grid();
#define GSYNC_CG() do { __builtin_amdgcn_fence(__ATOMIC_RELEASE, "agent"); grid.sync(); __builtin_amdgcn_fence(__ATOMIC_ACQUIRE, "agent"); } while (0)
    XcdBarrier xbar;
    { volatile LAS unsigned* st = (volatile LAS unsigned*)(L + 159488);
      if (threadIdx.x < 2) st[threadIdx.x] = 0u;
      __syncthreads();
      const Params pb_ = load_params();
      xbar = xcd_barrier_post((unsigned*)(pb_.ws + OFF_BAR), st); }
#define GSYNC() do { if (gridDim.x == 256) xcd_barrier(xbar); else GSYNC_CG(); } while (0)
#define TIDS const int tid = threadIdx.x, lane = tid & 63, wid = __builtin_amdgcn_readfirstlane(tid >> 6); const int G = gridDim.x, bid = blockIdx.x, gw = bid * 8 + wid, NGW = G * 8; (void)lane; (void)gw; (void)NGW; (void)G; (void)bid
    { TIDS; const Params p = load_params();
      mod_gemv(p, L, bid, G);
      if (G == 256) { if (bid >= 32) convert_weights(p.ffn1_w_in, D, NUP, NUP, 1, (bf16_t*)(p.ws + OFF_WT_FFN_IN), L, (bid - 32) * 8 + wid, 224 * 8, wid, lane); }
      else convert_weights(p.ffn1_w_in, D, NUP, NUP, 1, (bf16_t*)(p.ws + OFF_WT_FFN_IN), L, gw, NGW, wid, lane);
      if (G != 256) {
          convert_weights(p.ffn1_w_out, FF, D, D, 0, (bf16_t*)(p.ws + OFF_WT_FFN_OUT), L, gw, NGW, wid, lane);
          convert_weights(p.w_in, D, 6176, NIN, 2, (bf16_t*)(p.ws + OFF_WT_IN), L, gw, NGW, wid, lane);
          convert_weights(p.w_out, D, D, D, 0, (bf16_t*)(p.ws + OFF_WT_OUT), L, gw, NGW, wid, lane);
      } }
    GSYNC();
    { TIDS; const Params p = load_params();
      if (G == 256) {
          norm_mod_batched(p.x, p.norm_g, (const float*)(p.ws + OFF_MOD), 0, (bf16_t*)(p.ws + OFF_H), L, bid, 256, wid, lane);
          norm_mod_phase(p.x, p.ctx, MX, MALL, p.norm_g, (const float*)(p.ws + OFF_MOD), 0, (bf16_t*)(p.ws + OFF_H), gw, NGW, lane);
      } else norm_mod_phase(p.x, p.ctx, 0, MALL, p.norm_g, (const float*)(p.ws + OFF_MOD), 0, (bf16_t*)(p.ws + OFF_H), gw, NGW, lane); }
    GSYNC();
    { const Params p = load_params();
      run_gemm(L, (const bf16_t*)(p.ws + OFF_H), (const bf16_t*)(p.ws + OFF_WT_FFN_IN), MALL, NUP, D, EpiSwiglu{(bf16_t*)(p.ws + OFF_G)});
      if (gridDim.x == 256 && blockIdx.x >= 24) { TIDS;
          convert_weights(p.ffn1_w_out, FF, D, D, 0, (bf16_t*)(p.ws + OFF_WT_FFN_OUT), L, (bid - 24) * 8 + wid, 232 * 8, wid, lane);
          convert_weights(p.w_in, D, 6176, NIN, 2, (bf16_t*)(p.ws + OFF_WT_IN), L, (bid - 24) * 8 + wid, 232 * 8, wid, lane);
          convert_weights(p.w_out, D, D, D, 0, (bf16_t*)(p.ws + OFF_WT_OUT), L, (bid - 24) * 8 + wid, 232 * 8, wid, lane); } }
    GSYNC();
    { const Params p = load_params();
      run_gemm(L, (const bf16_t*)(p.ws + OFF_G), (const bf16_t*)(p.ws + OFF_WT_FFN_OUT), MX, D, FF, EpiResid{p.x, p.ctx, p.out, (float*)(p.ws + OFF_CTX1), (const float*)(p.ws + OFF_MOD), 2, 0.5f, 0}); }
    GSYNC();
    { TIDS; const Params p = load_params();
      if (G == 256) {
          float* Pp = (float*)(p.ws + OFF_CTX1);
          if (bid < 128) {
              const int half = bid >> 6, koff = half ? 2816 : 0;
              pg8::Gemm g{(const bf16_t*)(p.ws + OFF_G) + (size_t)MX * FF + koff, (const bf16_t*)(p.ws + OFF_WT_FFN_OUT) + koff, MC, D, half ? 2688 : 2816, FF};
              pg8::StaticOrder S; S.init(MC, D, 64, bid & 63);
              const EpiPartial E{Pp + (size_t)half * MC * D};
              pg8::gemm_phase<EpiPartial, pg8::StaticOrder, false>(L, g, S, E, nullptr);
              __syncthreads();
              convert_weights(p.ffn2_w_in, D, NUP, NUP, 1, (bf16_t*)(p.ws + OFF_WT_FFN_IN), L, bid * 8 + wid, 128 * 8, wid, lane, 0, 2);
          } else {
              norm_mod_batched(p.out, p.norm_g + D, (const float*)(p.ws + OFF_MOD), 3, (bf16_t*)(p.ws + OFF_H), L, bid - 128, 128, wid, lane);
              convert_weights(p.ffn2_w_in, D, NUP, NUP, 1, (bf16_t*)(p.ws + OFF_WT_FFN_IN), L, (bid - 128) * 8 + wid, 128 * 8, wid, lane, 1, 2);
          }
      } else if (G >= 128) {
          if (bid < 64) {
              pg8::Gemm g{(const bf16_t*)(p.ws + OFF_G) + (size_t)MX * FF, (const bf16_t*)(p.ws + OFF_WT_FFN_OUT), MC, D, FF}; pg8::StaticOrder S; S.init(MC, D, 64, bid);
              const EpiResid E{p.ctx, p.ctx, (float*)(p.ws + OFF_CTX1), (float*)(p.ws + OFF_CTX1), (const float*)(p.ws + OFF_MOD), 2, 0.5f, 1};
              pg8::gemm_phase<EpiResid, pg8::StaticOrder, false>(L, g, S, E, nullptr);
              __syncthreads();
          } else {
              const int gw2 = (bid - 64) * 8 + wid, NGW2 = (G - 64) * 8;
              if (G == 256) norm_mod_batched(p.out, p.norm_g + D, (const float*)(p.ws + OFF_MOD), 3, (bf16_t*)(p.ws + OFF_H), L, bid - 64, 192, wid, lane);
              else norm_mod_phase(p.out, p.out, 0, MX, p.norm_g + D, (const float*)(p.ws + OFF_MOD), 3, (bf16_t*)(p.ws + OFF_H), gw2, NGW2, lane);
              convert_weights(p.ffn2_w_in, D, NUP, NUP, 1, (bf16_t*)(p.ws + OFF_WT_FFN_IN), L, gw2, NGW2, wid, lane);
          }
      } else {
          run_gemm(L, (const bf16_t*)(p.ws + OFF_G) + (size_t)MX * FF, (const bf16_t*)(p.ws + OFF_WT_FFN_OUT), MC, D, FF, EpiResid{p.ctx, p.ctx, (float*)(p.ws + OFF_CTX1), (float*)(p.ws + OFF_CTX1), (const float*)(p.ws + OFF_MOD), 2, 0.5f, 1});
          norm_mod_phase(p.out, p.out, 0, MX, p.norm_g + D, (const float*)(p.ws + OFF_MOD), 3, (bf16_t*)(p.ws + OFF_H), gw, NGW, lane);
          convert_weights(p.ffn2_w_in, D, NUP, NUP, 1, (bf16_t*)(p.ws + OFF_WT_FFN_IN), L, gw, NGW, wid, lane);
      } }
    GSYNC();
    { TIDS; const Params p = load_params();
      if (G == 256) ctx_norm_from_partials(p.ctx, (const float*)(p.ws + OFF_CTX1), (const float*)(p.ws + OFF_CTX1) + (size_t)MC * D, p.norm_g + D, (const float*)(p.ws + OFF_MOD), (bf16_t*)(p.ws + OFF_H), gw, NGW, lane);
      else norm_mod_phase(p.out, (const float*)(p.ws + OFF_CTX1), MX, MALL, p.norm_g + D, (const float*)(p.ws + OFF_MOD), 3, (bf16_t*)(p.ws + OFF_H), gw, NGW, lane);
      if (G != 256) convert_weights(p.ffn2_w_out, FF, D, D, 0, (bf16_t*)(p.ws + OFF_WT_FFN_OUT), L, gw, NGW, wid, lane); }
    GSYNC();
    { const Params p = load_params();
      pg8::Gemm g{(const bf16_t*)(p.ws + OFF_H), (const bf16_t*)(p.ws + OFF_WT_IN), MALL, NIN, D}; const InprojOrder S{(int)gridDim.x, (int)blockIdx.x};
      const EpiInproj E{p.ws};
      pg8::gemm_phase<EpiInproj, InprojOrder, false>(L, g, S, E, nullptr);
      __syncthreads();
      if (gridDim.x == 256 && blockIdx.x >= 168) { TIDS; convert_weights(p.ffn2_w_out, FF, D, D, 0, (bf16_t*)(p.ws + OFF_WT_FFN_OUT), L, (bid - 168) * 8 + wid, 88 * 8, wid, lane); } }
    GSYNC();
    for (int round = 0; round < NROUND; ++round) {
        { const Params p = load_params(); const int G = gridDim.x, bid = blockIdx.x;
          if (G == 256) {
              for (int it = bid; it < 1152; it += 256) dn_prep_item(p, L, round * 4 + it / 288, (it >> 3) % 36, it & 7);
              if (bid < 128) { const int m = round * 128 + bid; chunk_mlp_item(p, L, m >> 7, (m >> 3) & 15, m & 7); }
              else { for (int q = 0; q < 3; ++q) { const int m = 256 + (round * 3 + q) * 128 + (bid - 128); chunk_mlp_item(p, L, m >> 7, (m >> 3) & 15, m & 7); } }
          } else {
              const int nitems = 1152 + (round == 0 ? 1024 : 0);
              for (int it = bid; it < nitems; it += G) {
                  if (it < 1152) { dn_prep_item(p, L, round * 4 + it / 288, (it >> 3) % 36, it & 7); }
                  else { const int m = it - 1152; chunk_mlp_item(p, L, m >> 7, (m >> 3) & 15, m & 7); }
              }
          } }
        GSYNC();
        { const Params p = load_params(); const int G = gridDim.x, bid = blockIdx.x;
          for (int c0 = bid; c0 < 256; c0 += G) { const int xq = c0 & 7, yq = c0 >> 3, ch = ((xq * 8 + (yq >> 2)) << 2) | (yq & 3); dn_scan(p, L, ch, round); __syncthreads(); } }
        GSYNC();
    }
    { TIDS; const Params p = load_params(); combine_phase(p, gw, NGW, lane); }
    GSYNC();
    { const Params p = load_params();
      run_gemm(L, (const bf16_t*)(p.ws + OFF_O), (const bf16_t*)(p.ws + OFF_WT_OUT), MX, D, D, EpiResid{p.out, p.out, p.out, p.out, (const float*)(p.ws + OFF_MOD), 5, 1.0f, 0}); }
    GSYNC();
    { TIDS; const Params p = load_params();
      if (G == 256) norm_mod_batched(p.out, p.norm_g + 2 * D, (const float*)(p.ws + OFF_MOD), 6, (bf16_t*)(p.ws + OFF_H), L, bid, 256, wid, lane);
      else norm_mod_phase(p.out, p.out, 0, MX, p.norm_g + 2 * D, (const float*)(p.ws + OFF_MOD), 6, (bf16_t*)(p.ws + OFF_H), gw, NGW, lane); }
    GSYNC();
    { const Params p = load_params();
      run_gemm(L, (const bf16_t*)(p.ws + OFF_H), (const bf16_t*)(p.ws + OFF_WT_FFN_IN), MX, NUP, D, EpiSwiglu{(bf16_t*)(p.ws + OFF_G)}); }
    GSYNC();
    { const Params p = load_params();
      run_gemm(L, (const bf16_t*)(p.ws + OFF_G), (const bf16_t*)(p.ws + OFF_WT_FFN_OUT), MX, D, FF, EpiResid{p.out, p.out, p.out, p.out, (const float*)(p.ws + OFF_MOD), 8, 0.5f, 0}); }
    GSYNC();
    { TIDS; const Params p = load_params(); final_norm_phase(p.out, p.final_g, gw, NGW, lane); }
}

extern "C" void kernel_launch(void* const* d_in, const int* in_sizes, int n_in, void* d_out, int out_size, void* d_ws, size_t ws_size, hipStream_t stream) {
    static int grid_blocks = 0;
    if (grid_blocks == 0) {
        if (n_in != 21 || ws_size < WS_END) { fprintf(stderr, "kernel_launch: unexpected n_in %d or ws_size %zu < %zu\n", n_in, ws_size, (size_t)WS_END); grid_blocks = -1; return; }
        int dev = 0, cus = 0, per_cu = 0;
        hipGetDevice(&dev);
        hipDeviceGetAttribute(&cus, hipDeviceAttributeMultiprocessorCount, dev);
        hipFuncSetAttribute((const void*)fwd_megakernel, hipFuncAttributeMaxDynamicSharedMemorySize, LDS_BYTES);
        hipOccupancyMaxActiveBlocksPerMultiprocessor(&per_cu, (const void*)fwd_megakernel, NT, LDS_BYTES);
        if (per_cu < 1) per_cu = 1;
        grid_blocks = cus * per_cu;
        (void)hipGetLastError();
    }
    if (grid_blocks < 0) return;
    Params p{};
    const float** pp = (const float**)&p;
    for (int i = 0; i < 21; ++i) pp[i] = (const float*)d_in[i];
    p.out = (float*)d_out; p.ws = (unsigned char*)d_ws;
    hipMemsetAsync((unsigned char*)d_ws + OFF_BAR, 0, 16384, stream);
    void* args[] = {&p};
    hipError_t e = hipLaunchCooperativeKernel((const void*)fwd_megakernel, dim3(grid_blocks), dim3(NT), args, LDS_BYTES, stream);
    if (e != hipSuccess) fprintf(stderr, "cooperative launch failed: %s (grid %d)\n", hipGetErrorString(e), grid_blocks);
}
```

```cpp
#include <hip/hip_runtime.h>
#include <hip/hip_cooperative_groups.h>
#include <cstdio>
namespace cg = cooperative_groups;
namespace pg8 {
#define PG8_LAS __attribute__((address_space(3)))
typedef unsigned short bf16_t;
typedef short bf16x8 __attribute__((ext_vector_type(8)));
typedef float f32x4 __attribute__((ext_vector_type(4)));
typedef unsigned u32x4 __attribute__((ext_vector_type(4)));
constexpr int BM = 256, BK = 64, HALF = 128, HTB = HALF * BK * 2  , STAGE_BYTES = 8 * HTB, NXCD = 8, WGM = 8;

__host__ __device__ __forceinline__ int lds_byte(int r, int c) { const int st = (r >> 4) * 2 + (c >> 5), rr = r & 15, cc = c & 31, ob = rr * 64 + cc * 2; return st * 1024 + (ob ^ (((ob >> 9) & 1) << 5)); }
__host__ __device__ __forceinline__ void stage_rc(int b, int& R, int& C) { const int st = b / 1024, sb = b % 1024, swz = sb ^ (((sb >> 9) & 1) << 5); R = (st >> 1) * 16 + swz / 64; C = (st & 1) * 32 + (swz % 64) / 2; }
__host__ __device__ __forceinline__ int perm32(int rho) { const int n = rho >> 4, i = rho & 15; return 8 * (i >> 2) + 4 * n + (i & 3); }

struct Unit { int pm, pn; };
struct Gemm { const bf16_t* A; const bf16_t* Bt; int M, N, K; int ld; };

struct StaticOrder {
    int nM, nN, nwg, G, c;
    __host__ __device__ void init(int M, int N, int G_, int c_) { nM = M / BM; nN = N / BM; nwg = nM * nN; G = G_; c = c_; }
    __host__ __device__ bool next(int i, Unit& u) const {
        const long L = (long)i * G + c; if (L >= nwg) return false;
        int wgid = (int)L; { const int q = nwg / NXCD, r = nwg % NXCD, xcd = wgid % NXCD, off = wgid / NXCD; wgid = (xcd < r ? xcd * (q + 1) : r * (q + 1) + (xcd - r) * q) + off; }
        const int nig = WGM * nN, gid = wgid / nig, fm = gid * WGM, gsz = (nM - fm) < WGM ? (nM - fm) : WGM;
        u.pm = fm + ((wgid % nig) % gsz); u.pn = (wgid % nig) / gsz; return true;
    }
    __device__ __forceinline__ void a_ready(const Unit&) const {}
    __device__ __forceinline__ void done(const Unit&) const {}
};
typedef float f32x2_cv __attribute__((ext_vector_type(2)));
typedef __bf16 bf16x2_cv __attribute__((ext_vector_type(2)));
__device__ __forceinline__ unsigned cvt_pk_bf16(float lo, float hi) { const f32x2_cv v = {lo, hi}; const bf16x2_cv r = __builtin_convertvector(v, bf16x2_cv); return __builtin_bit_cast(unsigned, r); }
template <class Epi, class Sched, bool STAMP = false>
__device__ __forceinline__ void gemm_phase(PG8_LAS unsigned char* lds, const Gemm g, const Sched& S, const Epi& E, unsigned long long* stamps) {
    const int tid = threadIdx.x, wid = __builtin_amdgcn_readfirstlane(tid >> 6), lane = tid & 63, wr = wid >> 2, wc = wid & 3, fr = lane & 15, fq = lane >> 4;
    const int K = g.K, nt = K / BK, LD = g.ld ? g.ld : g.K;
    int ts_lo = 0, ts_hi = 0, nts = 0; const unsigned long long rt_entry = STAMP ? (unsigned long long)wall_clock64() : 0ull;
#define PG8_STAMP() do { if (STAMP && wid == 0 && nts < 64) { const unsigned long long _c = (unsigned long long)clock64(); \
        ts_lo = (lane == nts) ? (int)(unsigned)_c : ts_lo; ts_hi = (lane == nts) ? (int)(unsigned)(_c >> 32) : ts_hi; ++nts; } } while (0)
    PG8_STAMP();
    unsigned voffA[2], voffB[2];
#pragma unroll
    for (int i = 0; i < 2; ++i) { int R, C; stage_rc(tid * 16 + i * 8192, R, C); const int Rb = Epi::PERM ? ((R & ~31) + perm32(R & 31)) : R;
        voffA[i] = (unsigned)(R * LD + C) * 2u; voffB[i] = (unsigned)(Rb * LD + C) * 2u; }
    const size_t kstep = (size_t)(BK * 2);
    const size_t hstep = (size_t)HALF * LD * 2;
    const size_t tstep = 2 * hstep;
    const unsigned ldsw = (unsigned)wid * 1024u;
    const int aoff = lds_byte(wr * 64 + fr, fq * 8), boff = lds_byte(wc * 32 + fr, fq * 8);
#define PG8_SA(b, h) (((b) * 2 + (h)) * HTB)
#define PG8_SB(b, h) ((4 + (b) * 2 + (h)) * HTB)
#define PG8_STAGE(bufoff, gbase, voff) do { _Pragma("unroll") for (int _i = 0; _i < 2; ++_i) \
        __builtin_amdgcn_global_load_lds((const unsigned*)((const char*)(gbase) + (voff)[_i]), (PG8_LAS unsigned*)(lds + (bufoff) + ldsw + _i * 8192), 16, 0, 0); } while (0)
#define PG8_LDA(dst, b, h) do { _Pragma("unroll") for (int m = 0; m < 4; ++m) _Pragma("unroll") for (int k = 0; k < 2; ++k) dst[m][k] = *(const PG8_LAS bf16x8*)(lds + PG8_SA(b, h) + aoff + m * 2048 + k * 1024); } while (0)
#define PG8_LDB(dst, b, h) do { _Pragma("unroll") for (int n = 0; n < 2; ++n) _Pragma("unroll") for (int k = 0; k < 2; ++k) dst[n][k] = *(const PG8_LAS bf16x8*)(lds + PG8_SB(b, h) + boff + n * 2048 + k * 1024); } while (0)
#define PG8_MMA(ai, bj, At, Bt) do { __builtin_amdgcn_s_setprio(1); _Pragma("unroll") for (int m = 0; m < 4; ++m) _Pragma("unroll") for (int n = 0; n < 2; ++n) _Pragma("unroll") for (int k = 0; k < 2; ++k) \
        acc[ai][bj][m][n] = __builtin_amdgcn_mfma_f32_16x16x32_bf16(Bt[n][k], At[m][k], acc[ai][bj][m][n], 0, 0, 0); __builtin_amdgcn_s_setprio(0); } while (0)
#define PG8_WAIT_V(n) asm volatile("s_waitcnt vmcnt(" #n ")" ::: "memory")
#define PG8_WAIT_L(n) asm volatile("s_waitcnt lgkmcnt(" #n ")" ::: "memory")
#define PG8_BAR __builtin_amdgcn_s_barrier()
#define PG8_SCHED __builtin_amdgcn_sched_barrier(0)
    Unit cur, nxt; int ui = 0;
    if (!S.next(0, cur)) return;
    f32x4 acc[2][2][4][2];
#pragma unroll
    for (int a = 0; a < 2; ++a)
#pragma unroll
        for (int b = 0; b < 2; ++b)
#pragma unroll
            for (int m = 0; m < 4; ++m)
#pragma unroll
                for (int n = 0; n < 2; ++n) acc[a][b][m][n] = (f32x4){0.f, 0.f, 0.f, 0.f};
    bf16x8 At[4][2], B0[2][2], B1[2][2];
    const char* cA = (const char*)g.A + (size_t)cur.pm * tstep; const char* cB = (const char*)g.Bt + (size_t)cur.pn * tstep;
    S.a_ready(cur);
    PG8_STAGE(PG8_SB(0, 0), cB, voffB); PG8_STAGE(PG8_SA(0, 0), cA, voffA); PG8_STAGE(PG8_SB(0, 1), cB + hstep, voffB); PG8_STAGE(PG8_SA(0, 1), cA + hstep, voffA);
    if (wr == 1) PG8_BAR;
    PG8_WAIT_V(4); PG8_BAR;
    PG8_STAGE(PG8_SB(1, 0), cB + kstep, voffB); PG8_STAGE(PG8_SA(1, 0), cA + kstep, voffA); PG8_STAGE(PG8_SB(1, 1), cB + hstep + kstep, voffB);
    PG8_WAIT_V(6); PG8_BAR;
    PG8_STAMP();
    for (;;) {
        const bool has_next = S.next(ui + 1, nxt);
        const char* nA = has_next ? (const char*)g.A + (size_t)nxt.pm * tstep : cA; const char* nB = has_next ? (const char*)g.Bt + (size_t)nxt.pn * tstep : cB;
        for (int t = 0; t < nt; t += 2) {
            const bool last = (t == nt - 2);
            const char* a1 = cA + (size_t)(t + 1) * kstep;
            const char* a2 = last ? nA : cA + (size_t)(t + 2) * kstep; const char* b2 = last ? nB : cB + (size_t)(t + 2) * kstep;
            const char* a3 = a2 + kstep; const char* b3 = b2 + kstep;
            if (last && has_next) S.a_ready(nxt);
            PG8_LDB(B0, 0, 0); PG8_SCHED; PG8_LDA(At, 0, 0); PG8_STAGE(PG8_SA(1, 1), a1 + hstep, voffA);
            PG8_WAIT_L(8); PG8_BAR; PG8_WAIT_L(0); PG8_MMA(0, 0, At, B0); PG8_BAR; PG8_SCHED;
            PG8_LDB(B1, 0, 1); PG8_STAGE(PG8_SB(0, 0), b2, voffB);
            PG8_BAR; PG8_WAIT_L(0); PG8_MMA(0, 1, At, B1); PG8_BAR;
            PG8_LDA(At, 0, 1); PG8_STAGE(PG8_SA(0, 0), a2, voffA);
            PG8_BAR; PG8_WAIT_L(0); PG8_MMA(1, 0, At, B0); PG8_BAR; PG8_SCHED;
            PG8_STAGE(PG8_SB(0, 1), b2 + hstep, voffB);
            PG8_WAIT_V(6); PG8_BAR; PG8_MMA(1, 1, At, B1); PG8_BAR;
            PG8_LDB(B0, 1, 0); PG8_SCHED; PG8_LDA(At, 1, 0); PG8_STAGE(PG8_SA(0, 1), a2 + hstep, voffA);
            PG8_WAIT_L(8); PG8_BAR; PG8_WAIT_L(0); PG8_MMA(0, 0, At, B0); PG8_BAR; PG8_SCHED;
            PG8_LDB(B1, 1, 1); PG8_STAGE(PG8_SB(1, 0), b3, voffB);
            PG8_BAR; PG8_WAIT_L(0); PG8_MMA(0, 1, At, B1); PG8_BAR;
            PG8_LDA(At, 1, 1); PG8_STAGE(PG8_SA(1, 0), a3, voffA);
            PG8_BAR; PG8_WAIT_L(0); PG8_MMA(1, 0, At, B0); PG8_BAR; PG8_SCHED;
            PG8_STAGE(PG8_SB(1, 1), b3 + hstep, voffB);
            PG8_WAIT_V(6); PG8_BAR; PG8_MMA(1, 1, At, B1); PG8_BAR;
        }
        PG8_STAMP();
        if constexpr (!Epi::AFTER_DRAIN) { E(acc, cur, wr, wc, fr, fq); S.done(cur); }
        PG8_STAMP();
        if (!has_next) break;
#pragma unroll
        for (int a = 0; a < 2; ++a)
#pragma unroll
            for (int b = 0; b < 2; ++b)
#pragma unroll
                for (int m = 0; m < 4; ++m)
#pragma unroll
                    for (int n = 0; n < 2; ++n) acc[a][b][m][n] = (f32x4){0.f, 0.f, 0.f, 0.f};
        cur = nxt; cA = nA; cB = nB; ++ui;
    }
    PG8_WAIT_V(0);
    if (wr == 0) PG8_BAR;
    PG8_BAR;
    if constexpr (Epi::AFTER_DRAIN) { E.fused(acc, cur, wr, wc, fr, fq, lds, wid, lane); S.done(cur); }
    PG8_STAMP();
    if (STAMP && wid == 0) { stamps[lane] = lane < nts ? (((unsigned long long)(unsigned)ts_hi << 32) | (unsigned)ts_lo) : 0ull;
        if (lane == 62) stamps[62] = rt_entry; if (lane == 63) stamps[63] = (unsigned long long)wall_clock64(); }
#undef PG8_STAMP
#undef PG8_SA
#undef PG8_SB
#undef PG8_STAGE
#undef PG8_LDA
#undef PG8_LDB
#undef PG8_MMA
#undef PG8_WAIT_V
#undef PG8_WAIT_L
#undef PG8_BAR
#undef PG8_SCHED
}
}

using pg8::bf16_t; using pg8::bf16x8; using pg8::f32x4; using pg8::u32x4; using pg8::Unit; using pg8::cvt_pk_bf16;
typedef unsigned u32x2 __attribute__((ext_vector_type(2)));
#define DI __device__ __forceinline__
#define LAS __attribute__((address_space(3)))
#define MFMA16(a, b, c) __builtin_amdgcn_mfma_f32_16x16x32_bf16((a), (b), (c), 0, 0, 0)

constexpr int NT = 512;
constexpr int D = 2048, FF = 5504, NUP = 11008, NIN = 6400;
constexpr int MX = 16384, MC = 2048, MALL = 18432;
constexpr int NMOD = 18432;
constexpr int LDS_BYTES = 159744;

constexpr size_t OFF_WT_FFN_IN = 0;
constexpr size_t OFF_WT_FFN_OUT = OFF_WT_FFN_IN + (size_t)NUP * D * 2;
constexpr size_t OFF_WT_OUT = OFF_WT_FFN_OUT + (size_t)D * FF * 2;
constexpr size_t OFF_MOD = OFF_WT_OUT + (size_t)D * D * 2;
constexpr size_t OFF_AB = OFF_MOD + (size_t)9 * NMOD * 4;
constexpr size_t OFF_SST = OFF_AB + (size_t)MALL * 32 * 4;
constexpr size_t OFF_Z0 = OFF_SST + (size_t)256 * 8192 * 4;
constexpr size_t OFF_G = OFF_Z0;
constexpr size_t OFF_ZQKV = OFF_Z0;
constexpr size_t OFF_ZG = OFF_ZQKV + (size_t)MALL * 3072 * 2;
constexpr size_t OFF_ZU = OFF_ZG + (size_t)MX * 1024 * 2;
constexpr size_t OFF_ZV = OFF_ZU + (size_t)MX * 1024 * 2;
constexpr size_t OFF_H = OFF_ZV + (size_t)MX * 1024 * 2;
constexpr size_t OFF_ODIR = OFF_H;
constexpr size_t OFF_WT_IN = OFF_H + (size_t)MALL * D * 2;
constexpr size_t OFF_CTX1 = OFF_WT_IN + (size_t)NIN * D * 2;
constexpr size_t OFF_PREP = OFF_WT_IN;
constexpr int PREP_STRIDE = 73984;
constexpr int PI_W = 0, PI_U = 16384, PI_QD = 32768, PI_KDT = 49152, PI_QK = 65536, PI_GL = 73728;
constexpr int NSTEP = 36, NROUND = 2, RSTEPS = NSTEP / NROUND;
constexpr int PREP_ITEMS = 8 * 8 * 2 * RSTEPS;
constexpr size_t OFF_O = OFF_PREP + (size_t)PREP_ITEMS * PREP_STRIDE;
constexpr size_t OFF_BAR = OFF_O + (size_t)MX * D * 2;
constexpr size_t WS_END = OFF_BAR + 16384;
static_assert(OFF_G + (size_t)MALL * FF * 2 <= OFF_H, "G vs H");
static_assert((size_t)2 * MX * 1024 * 2 <= (size_t)MALL * D * 2, "ODIR fits H");
static_assert(OFF_CTX1 + (size_t)2 * MC * D * 4 <= OFF_O, "ctx1 / split-K partials");

struct Params {
    const float *x, *c, *ctx, *c_ctx, *w_mod, *b_mod, *norm_g, *ffn1_w_in, *ffn1_w_out, *w_in, *conv_w, *a_log, *dt_bias, *head_norm_g,
        *spatial_w, *spatial_b, *mlp_norm_g, *w_out, *ffn2_w_in, *ffn2_w_out, *final_g;
    float* out; unsigned char* ws;
};

typedef const __attribute__((address_space(4))) unsigned long long* kargp_t;
typedef __attribute__((address_space(1))) unsigned char* gptr_t;
DI Params load_params() {
    kargp_t k = (kargp_t)__builtin_amdgcn_kernarg_segment_ptr();
    asm volatile("" : "+s"(k));
    Params q;
#define LP(i) ((gptr_t)k[i])
    q.x = (const float*)LP(0); q.c = (const float*)LP(1); q.ctx = (const float*)LP(2); q.c_ctx = (const float*)LP(3); q.w_mod = (const float*)LP(4);
    q.b_mod = (const float*)LP(5); q.norm_g = (const float*)LP(6); q.ffn1_w_in = (const float*)LP(7); q.ffn1_w_out = (const float*)LP(8); q.w_in = (const float*)LP(9);
    q.conv_w = (const float*)LP(10); q.a_log = (const float*)LP(11); q.dt_bias = (const float*)LP(12); q.head_norm_g = (const float*)LP(13); q.spatial_w = (const float*)LP(14);
    q.spatial_b = (const float*)LP(15); q.mlp_norm_g = (const float*)LP(16); q.w_out = (const float*)LP(17); q.ffn2_w_in = (const float*)LP(18); q.ffn2_w_out = (const float*)LP(19);
    q.final_g = (const float*)LP(20); q.out = (float*)LP(21); q.ws = (unsigned char*)LP(22);
#undef LP
    return q;
}
DI float bflo(unsigned u) { return __uint_as_float(u << 16); }
DI float bfhi(unsigned u) { return __uint_as_float(u & 0xffff0000u); }
DI float bf2f(bf16_t b) { return __uint_as_float(((unsigned)b) << 16); }
DI unsigned f2bf(float f) { unsigned u = __float_as_uint(f); return (u + 0x7fffu + ((u >> 16) & 1u)) >> 16; }
DI float silu_f(float x) { return x * __builtin_amdgcn_rcpf(1.0f + __expf(-x)); }
DI float gelu_f(float x) { const float u = 1.5957691216057308f * (x + 0.044715f * x * x * x); return x * __builtin_amdgcn_rcpf(1.0f + __expf(-u)); }
DI float wave_sum(float v) {
#pragma unroll
    for (int o = 1; o < 64; o <<= 1) v += __shfl_xor(v, o);
    return v;
}

struct EpiSwiglu {
    static constexpr bool PERM = true, AFTER_DRAIN = false;
    bf16_t* G;
    DI void operator()(const f32x4 (&acc)[2][2][4][2], const Unit& u, int wr, int wc, int fr, int fq) const {
        const int row0 = u.pm * 256 + wr * 64 + fr, col0 = u.pn * 128 + wc * 32 + 8 * fq;
#pragma unroll
        for (int ai = 0; ai < 2; ++ai)
#pragma unroll
            for (int m = 0; m < 4; ++m) {
                const f32x4 a0 = acc[ai][0][m][0], a1 = acc[ai][0][m][1], b0 = acc[ai][1][m][0], b1 = acc[ai][1][m][1];
                u32x4 w;
                w.x = cvt_pk_bf16(silu_f(a0[0]) * b0[0], silu_f(a0[1]) * b0[1]); w.y = cvt_pk_bf16(silu_f(a0[2]) * b0[2], silu_f(a0[3]) * b0[3]);
                w.z = cvt_pk_bf16(silu_f(a1[0]) * b1[0], silu_f(a1[1]) * b1[1]); w.w = cvt_pk_bf16(silu_f(a1[2]) * b1[2], silu_f(a1[3]) * b1[3]);
                *(u32x4*)(G + (size_t)(row0 + ai * 128 + m * 16) * FF + col0) = w;
            }
    }
};
struct EpiResid {
    static constexpr bool PERM = false, AFTER_DRAIN = false;
    const float* srcx; const float* srcc; float* dstx; float* dstc; const float* mod; int gate_idx; float coef; int ctx_only;
    DI void operator()(const f32x4 (&acc)[2][2][4][2], const Unit& u, int wr, int wc, int fr, int fq) const {
        const bool isc = ctx_only || u.pm >= 64; const int mb = isc ? 8 : (u.pm >> 3);
        const int row0 = ((isc && !ctx_only) ? (u.pm - 64) : u.pm) * 256 + wr * 64 + fr, col0 = u.pn * 256 + wc * 32 + 4 * fq;
        const float* src = isc ? srcc : srcx; float* dst = isc ? dstc : dstx;
        const float* gate = mod + (size_t)mb * NMOD + gate_idx * D + col0;
        f32x4 gv[2][2];
#pragma unroll
        for (int bj = 0; bj < 2; ++bj)
#pragma unroll
            for (int n = 0; n < 2; ++n) gv[bj][n] = *(const f32x4*)(gate + bj * 128 + n * 16) * coef;
#pragma unroll
        for (int ai = 0; ai < 2; ++ai)
#pragma unroll
            for (int m = 0; m < 4; ++m) {
                const size_t off = (size_t)(row0 + ai * 128 + m * 16) * D + col0;
#pragma unroll
                for (int bj = 0; bj < 2; ++bj)
#pragma unroll
                    for (int n = 0; n < 2; ++n) {
                        const f32x4 s = *(const f32x4*)(src + off + bj * 128 + n * 16);
                        *(f32x4*)(dst + off + bj * 128 + n * 16) = s + gv[bj][n] * acc[ai][bj][m][n];
                    }
                if (m & 1) asm volatile("" ::: "memory");
            }
    }
};
struct EpiPartial {
    static constexpr bool PERM = false, AFTER_DRAIN = false;
    float* P;
    DI void operator()(const f32x4 (&acc)[2][2][4][2], const Unit& u, int wr, int wc, int fr, int fq) const {
        const int row0 = u.pm * 256 + wr * 64 + fr, col0 = u.pn * 256 + wc * 32 + 4 * fq;
#pragma unroll
        for (int ai = 0; ai < 2; ++ai)
#pragma unroll
            for (int m = 0; m < 4; ++m) {
                float* rp = P + (size_t)(row0 + ai * 128 + m * 16) * D + col0;
#pragma unroll
                for (int bj = 0; bj < 2; ++bj)
#pragma unroll
                    for (int n = 0; n < 2; ++n) *(f32x4*)(rp + bj * 128 + n * 16) = acc[ai][bj][m][n];
            }
    }
};
struct EpiInproj {
    static constexpr bool PERM = true, AFTER_DRAIN = false;
    unsigned char* ws;
    DI void operator()(const f32x4 (&acc)[2][2][4][2], const Unit& u, int wr, int wc, int fr, int fq) const {
        const int row0 = u.pm * 256 + wr * 64 + fr;
        if (u.pn == 24) {
            if (wc == 0) {
                float* AB = (float*)(ws + OFF_AB);
#pragma unroll
                for (int ai = 0; ai < 2; ++ai)
#pragma unroll
                    for (int m = 0; m < 4; ++m) {
                        float* rp = AB + (size_t)(row0 + ai * 128 + m * 16) * 32 + 8 * fq;
                        *(f32x4*)rp = acc[ai][0][m][0]; *(f32x4*)(rp + 4) = acc[ai][0][m][1];
                    }
            }
            return;
        }
        if (u.pn >= 12 && u.pm >= 64) return;
        int act, ld, colt; bf16_t* base;
        if (u.pn < 12) { act = 0; ld = 3072; colt = u.pn * 256; base = (bf16_t*)(ws + OFF_ZQKV); }
        else if (u.pn < 16) { act = 1; ld = 1024; colt = (u.pn - 12) * 256; base = (bf16_t*)(ws + OFF_ZG); }
        else if (u.pn < 20) { act = 2; ld = 1024; colt = (u.pn - 16) * 256; base = (bf16_t*)(ws + OFF_ZU); }
        else { act = 2; ld = 1024; colt = (u.pn - 20) * 256; base = (bf16_t*)(ws + OFF_ZV); }
        const int col0 = colt + wc * 32 + 8 * fq;
#pragma unroll
        for (int ai = 0; ai < 2; ++ai)
#pragma unroll
            for (int m = 0; m < 4; ++m) {
                bf16_t* rowp = base + (size_t)(row0 + ai * 128 + m * 16) * ld + col0;
#pragma unroll
                for (int bj = 0; bj < 2; ++bj) {
                    f32x4 v0 = acc[ai][bj][m][0], v1 = acc[ai][bj][m][1];
                    if (act == 1) {
#pragma unroll
                        for (int j = 0; j < 4; ++j) { v0[j] = silu_f(v0[j]); v1[j] = silu_f(v1[j]); }
                    } else if (act == 2) {
#pragma unroll
                        for (int j = 0; j < 4; ++j) { v0[j] = gelu_f(v0[j]); v1[j] = gelu_f(v1[j]); }
                    }
                    u32x4 w; w.x = cvt_pk_bf16(v0[0], v0[1]); w.y = cvt_pk_bf16(v0[2], v0[3]); w.z = cvt_pk_bf16(v1[0], v1[1]); w.w = cvt_pk_bf16(v1[2], v1[3]);
                    *(u32x4*)(rowp + bj * 128) = w;
                }
            }
    }
};

DI int src_col(int mode, int n) {
    if (mode == 1) { const int pn = n >> 8, j = n & 255; return j < 128 ? pn * 128 + j : FF + pn * 128 + (j - 128); }
    if (mode == 2) { if (n < 4096) return n; if (n < 6144) return n + 32; if (n < 6176) return n - 6144 + 4096; return -1; }
    return n;
}
DI void transpose_item(const float* W, int K, int N, int Ndst, int mode, bf16_t* WT, LAS float* scr, int item, int lane) {
    const int nblk = Ndst / 64, kb = item / nblk, nb = item % nblk, k0 = 64 * kb, n0 = 64 * nb;
    const int rsub = lane >> 4, cg = lane & 15;
    const int s0 = src_col(mode, n0 + cg * 4);
    f32x4 v[16];
    if (s0 >= 0) {
        const float* wp = W + (size_t)(k0 + rsub) * N + s0;
#pragma unroll
        for (int i = 0; i < 16; ++i) v[i] = __builtin_nontemporal_load((const f32x4*)(wp + (size_t)(i * 4) * N));
    } else {
#pragma unroll
        for (int i = 0; i < 16; ++i) v[i] = (f32x4){0.f, 0.f, 0.f, 0.f};
    }
#pragma unroll
    for (int i = 0; i < 16; ++i) { LAS float* d = scr + (i * 4 + rsub) * 65 + cg * 4; d[0] = v[i].x; d[1] = v[i].y; d[2] = v[i].z; d[3] = v[i].w; }
    asm volatile("s_waitcnt lgkmcnt(0)" ::: "memory");
    const int c = lane & 7, nl = lane >> 3;
#pragma unroll
    for (int j = 0; j < 8; ++j) {
        const int n = nl + 8 * j; const LAS float* sp = scr + (8 * c) * 65 + n;
        u32x4 o; o.x = cvt_pk_bf16(sp[0 * 65], sp[1 * 65]); o.y = cvt_pk_bf16(sp[2 * 65], sp[3 * 65]); o.z = cvt_pk_bf16(sp[4 * 65], sp[5 * 65]); o.w = cvt_pk_bf16(sp[6 * 65], sp[7 * 65]);
        *(u32x4*)(WT + (size_t)(n0 + n) * K + k0 + 8 * c) = o;
    }
    asm volatile("s_waitcnt lgkmcnt(0)" ::: "memory");
}
DI void convert_weights(const float* W, int K, int N, int Ndst, int mode, bf16_t* WT, LAS unsigned char* L, int gw, int NGW, int wid, int lane, int sel = 0, int nsel = 1) {
    LAS float* scr = (LAS float*)(L + wid * 16640);
    const int nitems = (K / 64) * (Ndst / 64);
    for (int it = gw * nsel + sel; it < nitems; it += NGW * nsel) transpose_item(W, K, N, Ndst, mode, WT, scr, it, lane);
}

DI void mod_gemv(const Params& p, LAS unsigned char* L, int bid, int G) {
    const int tid = threadIdx.x, lane = tid & 63, wid = tid >> 6;
    LAS float* sc = (LAS float*)L;
    LAS float* red = (LAS float*)(L + 9 * 2048 * 4);
    for (int i = tid; i < 9 * 2048; i += NT) { const int r = i >> 11, k = i & 2047; const float v = r < 8 ? p.c[r * 2048 + k] : p.c_ctx[k]; sc[i] = silu_f(v); }
    __syncthreads();
    float* MOD = (float*)(p.ws + OFF_MOD);
    const int cgi = lane & 15, ksub = lane >> 4, ks = wid * 4 + ksub;
    for (int item = bid; item < NMOD / 64; item += G) {
        const int n0 = item * 64;
        f32x4 acc[9];
#pragma unroll
        for (int r = 0; r < 9; ++r) acc[r] = (f32x4){0.f, 0.f, 0.f, 0.f};
        const float* wp = p.w_mod + (size_t)(ks * 64) * NMOD + n0 + cgi * 4;
#pragma unroll 8
        for (int kk = 0; kk < 64; ++kk) {
            const f32x4 wv = __builtin_nontemporal_load((const f32x4*)(wp + (size_t)kk * NMOD));
#pragma unroll
            for (int r = 0; r < 9; ++r) acc[r] += wv * sc[r * 2048 + ks * 64 + kk];
        }
#pragma unroll
        for (int r = 0; r < 9; ++r)
#pragma unroll
            for (int j = 0; j < 4; ++j) { float v = acc[r][j]; v += __shfl_xor(v, 16); v += __shfl_xor(v, 32); acc[r][j] = v; }
        if (ksub == 0) {
#pragma unroll
            for (int r = 0; r < 9; ++r) *(LAS f32x4*)(red + (wid * 9 + r) * 64 + cgi * 4) = acc[r];
        }
        __syncthreads();
        for (int i = tid; i < 9 * 64; i += NT) {
            const int r = i >> 6, col = i & 63; float s = p.b_mod[n0 + col];
#pragma unroll
            for (int w = 0; w < 8; ++w) s += red[(w * 9 + r) * 64 + col];
            MOD[(size_t)r * NMOD + n0 + col] = s;
        }
        __syncthreads();
    }
}

DI void norm_mod_phase(const float* srcx, const float* srcc, int row0, int nrows, const float* g, const float* mod, int shift_idx, bf16_t* H, int gw, int NGW, int lane) {
    gw += row0;
    f32x4 nx[8];
    if (gw < nrows) { const float* src = gw < MX ? srcx + (size_t)gw * D : srcc + (size_t)(gw - MX) * D; const f32x4* xr = (const f32x4*)src + lane;
#pragma unroll
        for (int j = 0; j < 8; ++j) nx[j] = xr[64 * j]; }
    for (int r = gw; r < nrows; r += NGW) {
        const int mb = r < MX ? (r >> 11) : 8;
        f32x4 v[8]; float ss = 0.f;
#pragma unroll
        for (int j = 0; j < 8; ++j) { v[j] = nx[j]; ss += (v[j].x * v[j].x + v[j].y * v[j].y) + (v[j].z * v[j].z + v[j].w * v[j].w); }
        const int rn = r + NGW;
        if (rn < nrows) { const float* src = rn < MX ? srcx + (size_t)rn * D : srcc + (size_t)(rn - MX) * D; const f32x4* xr = (const f32x4*)src + lane;
#pragma unroll
            for (int j = 0; j < 8; ++j) nx[j] = xr[64 * j]; }
        const float rstd = rsqrtf(wave_sum(ss) * (1.0f / D) + 1e-6f);
        const float* sh = mod + (size_t)mb * NMOD + shift_idx * D; const float* scl = sh + D;
        u32x2* o8 = (u32x2*)(H + (size_t)r * D) + lane;
#pragma unroll
        for (int j = 0; j < 8; ++j) {
            const int c = (lane + 64 * j) * 4;
            const f32x4 gg = *(const f32x4*)(g + c), s1 = *(const f32x4*)(scl + c), s0 = *(const f32x4*)(sh + c);
            const f32x4 y = (v[j] * rstd) * gg * (s1 + 1.0f) + s0;
            u32x2 w; w.x = cvt_pk_bf16(y.x, y.y); w.y = cvt_pk_bf16(y.z, y.w); o8[64 * j] = w;
        }
    }
}
DI void norm_mod_batched(const float* src, const float* g, const float* mod, int shift_idx, bf16_t* H, LAS unsigned char* L, int q, int P, int wid, int lane) {
    const int per = P >> 3, b = q / per, j = q - b * per;
    LAS float* gam = (LAS float*)L; LAS float* shf = gam + 2048;
    { const float* sh = mod + (size_t)b * NMOD + shift_idx * D; const float* scl = sh + D;
      for (int i = threadIdx.x; i < 2048; i += NT) { gam[i] = g[i] * (1.0f + scl[i]); shf[i] = sh[i]; } }
    __syncthreads();
    const int k0 = j + wid * per, kstep = 8 * per;
    f32x4 nx[8];
    if (k0 < 2048) { const f32x4* xr = (const f32x4*)(src + ((size_t)b * 2048 + k0) * D) + lane;
#pragma unroll
        for (int jj = 0; jj < 8; ++jj) nx[jj] = xr[64 * jj]; }
    for (int k = k0; k < 2048; k += kstep) {
        const size_t r = (size_t)b * 2048 + k;
        f32x4 v[8]; float ss = 0.f;
#pragma unroll
        for (int jj = 0; jj < 8; ++jj) { v[jj] = nx[jj]; ss += (v[jj].x * v[jj].x + v[jj].y * v[jj].y) + (v[jj].z * v[jj].z + v[jj].w * v[jj].w); }
        const int kn = k + kstep;
        if (kn < 2048) { const f32x4* xr = (const f32x4*)(src + ((size_t)b * 2048 + kn) * D) + lane;
#pragma unroll
            for (int jj = 0; jj < 8; ++jj) nx[jj] = xr[64 * jj]; }
        const float rstd = rsqrtf(wave_sum(ss) * (1.0f / D) + 1e-6f);
        u32x2* o8 = (u32x2*)(H + r * D) + lane;
#pragma unroll
        for (int jj = 0; jj < 8; ++jj) {
            const int c = (lane + 64 * jj) * 4;
            const f32x4 y = (v[jj] * rstd) * *(const LAS f32x4*)(gam + c) + *(const LAS f32x4*)(shf + c);
            u32x2 w; w.x = cvt_pk_bf16(y.x, y.y); w.y = cvt_pk_bf16(y.z, y.w); o8[64 * jj] = w;
        }
    }
    __syncthreads();
}
DI void ctx_norm_from_partials(const float* ctx, const float* Pa, const float* Pb, const float* g, const float* mod, bf16_t* H, int gw, int NGW, int lane) {
    const float* m8 = mod + (size_t)8 * NMOD;
    for (int r = gw; r < MC; r += NGW) {
        const f32x4* xr = (const f32x4*)(ctx + (size_t)r * D) + lane; const f32x4* pa = (const f32x4*)(Pa + (size_t)r * D) + lane; const f32x4* pb = (const f32x4*)(Pb + (size_t)r * D) + lane;
        f32x4 v[8]; float ss = 0.f;
#pragma unroll
        for (int j = 0; j < 8; ++j) {
            const int c = (lane + 64 * j) * 4;
            const f32x4 gt = *(const f32x4*)(m8 + 2 * D + c) * 0.5f;
            v[j] = xr[64 * j] + gt * (pa[64 * j] + pb[64 * j]);
            ss += (v[j].x * v[j].x + v[j].y * v[j].y) + (v[j].z * v[j].z + v[j].w * v[j].w);
        }
        const float rstd = rsqrtf(wave_sum(ss) * (1.0f / D) + 1e-6f);
        u32x2* o8 = (u32x2*)(H + (size_t)(MX + r) * D) + lane;
#pragma unroll
        for (int j = 0; j < 8; ++j) {
            const int c = (lane + 64 * j) * 4;
            const f32x4 gg = *(const f32x4*)(g + c), s1 = *(const f32x4*)(m8 + 4 * D + c), s0 = *(const f32x4*)(m8 + 3 * D + c);
            const f32x4 y = (v[j] * rstd) * gg * (s1 + 1.0f) + s0;
            u32x2 w; w.x = cvt_pk_bf16(y.x, y.y); w.y = cvt_pk_bf16(y.z, y.w); o8[64 * j] = w;
        }
    }
}
DI void final_norm_phase(float* xo, const float* g, int gw, int NGW, int lane) {
    f32x4 nx[8];
    if (gw < MX) { const f32x4* xr = (const f32x4*)(xo + (size_t)gw * D) + lane;
#pragma unroll
        for (int j = 0; j < 8; ++j) nx[j] = xr[64 * j]; }
    for (int r = gw; r < MX; r += NGW) {
        f32x4* xw = (f32x4*)(xo + (size_t)r * D) + lane;
        f32x4 v[8]; float ss = 0.f;
#pragma unroll
        for (int j = 0; j < 8; ++j) { v[j] = nx[j]; ss += (v[j].x * v[j].x + v[j].y * v[j].y) + (v[j].z * v[j].z + v[j].w * v[j].w); }
        const int rn = r + NGW;
        if (rn < MX) { const f32x4* xr = (const f32x4*)(xo + (size_t)rn * D) + lane;
#pragma unroll
            for (int j = 0; j < 8; ++j) nx[j] = xr[64 * j]; }
        const float rstd = rsqrtf(wave_sum(ss) * (1.0f / D) + 1e-6f);
#pragma unroll
        for (int j = 0; j < 8; ++j) { const int c = (lane + 64 * j) * 4; xw[64 * j] = (v[j] * rstd) * *(const f32x4*)(g + c); }
    }
}

constexpr int PL_QN = 0, PL_KN = 17408, PL_KT = 34816, PL_VT = 53248, PL_KK = 71680, PL_QK = 88320, PL_LC1 = 104960, PL_TB = 121344, PL_VEC = 158208;
static_assert(PL_VEC + 1024 <= LDS_BYTES, "prep lds");

DI void dn_prep_item(const Params& p, LAS unsigned char* L, int b, int c, int h) {
    int tid_ = threadIdx.x; asm volatile("" : "+v"(tid_));
    const int tid = tid_, lane = tid & 63, wid = tid >> 6, fr = lane & 15, fq = lane >> 4;
    LAS bf16_t* Qn = (LAS bf16_t*)(L + PL_QN); LAS bf16_t* Kn = (LAS bf16_t*)(L + PL_KN);
    LAS bf16_t* KT = (LAS bf16_t*)(L + PL_KT); LAS bf16_t* VT = (LAS bf16_t*)(L + PL_VT);
    LAS float* KKf = (LAS float*)(L + PL_KK); LAS float* QKf = (LAS float*)(L + PL_QK);
    int base_row, seq_lo, seq_hi;
    if (c < 4) { seq_lo = MX + b * 256; seq_hi = seq_lo + 256; base_row = seq_lo + c * 64; }
    else { seq_lo = b * 2048; seq_hi = seq_lo + 2048; base_row = seq_lo + (c - 4) * 64; }
    const bool is_lat = c >= 4;
    const int dw = __builtin_amdgcn_readfirstlane(wid) & 1;
#define SLOT_OF(dd) ((size_t)(((((b & 3) * 8 + h) * 2 + (dd)) * 36) + ((dd) == 0 ? c : (c < 4 ? 3 - c : 39 - c))))
#define LC_OF(dd) ((LAS float*)(L + ((dd) ? PL_LC1 : PL_KN)))
#define TB_OF(dd) ((LAS bf16_t*)(L + PL_TB + (dd) * 18432))
#define TBG_OF(dd) ((LAS bf16_t*)(L + PL_TB + (dd) * 18432 + 9216))
#define VGC_OF(dd) ((LAS float*)(L + PL_VEC) + (dd) * 128)

    float ab_a = 0.f, ab_b = 0.f;
    if (wid < 2) {
        const int tok = dw ? 63 - lane : lane;
        const float* AB = (const float*)(p.ws + OFF_AB) + (size_t)(base_row + tok) * 32;
        ab_a = AB[dw * 8 + h]; ab_b = AB[16 + dw * 8 + h];
    }
    LAS bf16_t* Zs = (LAS bf16_t*)(L + PL_KK);
    LAS float* Ws = (LAS float*)(L + PL_KK + 53312);
    {
        const bf16_t* Z = (const bf16_t*)(p.ws + OFF_ZQKV);
        u32x4 zr[7]; f32x4 wr4 = (f32x4){0.f, 0.f, 0.f, 0.f};
#pragma unroll
        for (int e = 0; e < 7; ++e) {
            const int idx = tid + NT * e; zr[e] = (u32x4){0u, 0u, 0u, 0u};
            if (idx < 68 * 48) {
                const int row = idx / 48, rem = idx - row * 48, seg = rem >> 4, c16 = rem & 15, rr = base_row - 2 + row;
                if (rr >= seq_lo && rr < seq_hi) zr[e] = *(const u32x4*)(Z + (size_t)rr * 3072 + seg * 1024 + h * 128 + c16 * 8);
            }
        }
        if (tid < 480) { const int j = tid / 96, rem = tid - j * 96, seg = rem >> 5, c4 = rem & 31; wr4 = *(const f32x4*)(p.conv_w + j * 3072 + seg * 1024 + h * 128 + c4 * 4); }
#pragma unroll
        for (int e = 0; e < 7; ++e) {
            const int idx = tid + NT * e;
            if (idx < 68 * 48) { const int row = idx / 48, rem = idx - row * 48, seg = rem >> 4, c16 = rem & 15; *(LAS u32x4*)(Zs + row * 392 + seg * 128 + c16 * 8) = zr[e]; }
        }
        if (tid < 480) { const int j = tid / 96, rem = tid - j * 96, seg = rem >> 5, c4 = rem & 31; *(LAS f32x4*)(Ws + j * 384 + seg * 128 + c4 * 4) = wr4; }
    }
    __syncthreads();
    {
        const int t = tid & 63, sg = tid >> 6;
        LAS float* ssb = (LAS float*)(L + PL_TB + 2 * 18432 - 4096);
        float yq[16], yk[16];
#pragma unroll
        for (int seg = 0; seg < 3; ++seg) {
            float y[16];
#pragma unroll
            for (int hf = 0; hf < 2; ++hf) {
                typedef float f32x2 __attribute__((ext_vector_type(2)));
                f32x2 ap[4];
#pragma unroll
                for (int i = 0; i < 4; ++i) ap[i] = (f32x2){0.f, 0.f};
#pragma unroll
                for (int j = 0; j < 5; ++j) {
                    const u32x4 zz = *(const LAS u32x4*)(Zs + (t + j) * 392 + seg * 128 + sg * 16 + hf * 8);
                    const LAS float* cw = Ws + j * 384 + seg * 128 + sg * 16 + hf * 8;
                    const f32x4 w0 = *(const LAS f32x4*)cw, w1 = *(const LAS f32x4*)(cw + 4);
                    ap[0] += (f32x2){w0.x, w0.y} * (f32x2){bflo(zz.x), bfhi(zz.x)}; ap[1] += (f32x2){w0.z, w0.w} * (f32x2){bflo(zz.y), bfhi(zz.y)};
                    ap[2] += (f32x2){w1.x, w1.y} * (f32x2){bflo(zz.z), bfhi(zz.z)}; ap[3] += (f32x2){w1.z, w1.w} * (f32x2){bflo(zz.w), bfhi(zz.w)};
                }
#pragma unroll
                for (int i = 0; i < 4; ++i) { y[hf * 8 + 2 * i] = silu_f(ap[i].x); y[hf * 8 + 2 * i + 1] = silu_f(ap[i].y); }
            }
            if (seg < 2) {
                float ss = 0.f;
#pragma unroll
                for (int i = 0; i < 16; ++i) ss += y[i] * y[i];
                ssb[(seg * 8 + sg) * 64 + t] = ss;
#pragma unroll
                for (int i = 0; i < 16; ++i) { if (seg == 0) yq[i] = y[i]; else yk[i] = y[i]; }
            } else {
                LAS bf16_t* dstT = VT + (sg * 16) * 72 + t;
#pragma unroll
                for (int i = 0; i < 16; ++i) dstT[i * 72] = (bf16_t)f2bf(y[i]);
            }
        }
        __syncthreads();
        float sq = 0.f, sk = 0.f;
#pragma unroll
        for (int w = 0; w < 8; ++w) { sq += ssb[w * 64 + t]; sk += ssb[(8 + w) * 64 + t]; }
        const float scq = rsqrtf(sq + 1e-6f) * 0.08838834764831845f, sck = rsqrtf(sk + 1e-6f);
#pragma unroll
        for (int i = 0; i < 16; ++i) { yq[i] *= scq; yk[i] *= sck; }
        {
            u32x4 w0, w1;
            w0.x = cvt_pk_bf16(yq[0], yq[1]); w0.y = cvt_pk_bf16(yq[2], yq[3]); w0.z = cvt_pk_bf16(yq[4], yq[5]); w0.w = cvt_pk_bf16(yq[6], yq[7]);
            w1.x = cvt_pk_bf16(yq[8], yq[9]); w1.y = cvt_pk_bf16(yq[10], yq[11]); w1.z = cvt_pk_bf16(yq[12], yq[13]); w1.w = cvt_pk_bf16(yq[14], yq[15]);
            LAS bf16_t* dq = Qn + t * 136 + sg * 16; *(LAS u32x4*)dq = w0; *(LAS u32x4*)(dq + 8) = w1;
            w0.x = cvt_pk_bf16(yk[0], yk[1]); w0.y = cvt_pk_bf16(yk[2], yk[3]); w0.z = cvt_pk_bf16(yk[4], yk[5]); w0.w = cvt_pk_bf16(yk[6], yk[7]);
            w1.x = cvt_pk_bf16(yk[8], yk[9]); w1.y = cvt_pk_bf16(yk[10], yk[11]); w1.z = cvt_pk_bf16(yk[12], yk[13]); w1.w = cvt_pk_bf16(yk[14], yk[15]);
            LAS bf16_t* dk2 = Kn + t * 136 + sg * 16; *(LAS u32x4*)dk2 = w0; *(LAS u32x4*)(dk2 + 8) = w1;
            LAS bf16_t* dstT = KT + (sg * 16) * 72 + t;
#pragma unroll
            for (int i = 0; i < 16; ++i) dstT[i * 72] = (bf16_t)f2bf(yk[i]);
        }
    }
    if (wid < 2) {
        LAS float* vgc = VGC_OF(dw); LAS float* vbeta = vgc + 64;
        const float xx = ab_a + p.dt_bias[dw * 8 + h];
        const float sp = xx > 20.f ? xx : log1pf(expf(xx));
        float gcv = -expf(p.a_log[dw * 8 + h]) * sp;
#pragma unroll
        for (int o = 1; o < 64; o <<= 1) { const float t = __shfl_up(gcv, o); if (lane >= o) gcv += t; }
        vgc[lane] = gcv; vbeta[lane] = 1.0f / (1.0f + expf(-ab_b));
    }
    __syncthreads();
    {
        const LAS bf16_t* Am = (wid >> 2) ? Qn : Kn; LAS float* Mo = (wid >> 2) ? QKf : KKf; const int ti = wid & 3;
        bf16x8 af[4];
#pragma unroll
        for (int k = 0; k < 4; ++k) af[k] = *(const LAS bf16x8*)(Am + (ti * 16 + fr) * 136 + k * 32 + fq * 8);
#pragma unroll
        for (int tj = 0; tj < 4; ++tj) {
            f32x4 acc = (f32x4){0.f, 0.f, 0.f, 0.f};
#pragma unroll
            for (int k = 0; k < 4; ++k) acc = MFMA16(af[k], *(const LAS bf16x8*)(Kn + (tj * 16 + fr) * 136 + k * 32 + fq * 8), acc);
#pragma unroll
            for (int j = 0; j < 4; ++j) Mo[(ti * 16 + fq * 4 + j) * 65 + tj * 16 + fr] = acc[j];
        }
    }
    __syncthreads();
#pragma unroll
    for (int dd = 0; dd < 2; ++dd) {
        const LAS float* vgc = VGC_OF(dd); const LAS float* vbeta = vgc + 64; LAS float* Lc = LC_OF(dd);
#pragma unroll
        for (int e = 0; e < 8; ++e) {
            const int idx = tid + NT * e, j = idx >> 6, i = idx & 63;
            const int ti = dd ? 63 - i : i, tj = dd ? 63 - j : j;
            Lc[idx] = (i > j) ? vbeta[i] * KKf[ti * 65 + tj] * __expf(vgc[i] - vgc[j]) : 0.f;
        }
    }
    __syncthreads();
    LAS bf16_t* XI = (LAS bf16_t*)(L + PL_KK);
#define AINVT_OF(dd) (XI + (dd) * 3840)
#define BINVR_OF(dd) (XI + (dd) * 3840 + 1280)
#define CR_OF(dd) (XI + (dd) * 3840 + 2560)
    if (wid < 4) {
        const int dd = __builtin_amdgcn_readfirstlane(wid) >> 1, blk = __builtin_amdgcn_readfirstlane(wid) & 1, o = blk * 32;
        const LAS float* vgc = VGC_OF(dd); const LAS float* vbeta = vgc + 64;
        LAS bf16_t* TB = TB_OF(dd); LAS bf16_t* TBG = TBG_OF(dd);
        unsigned lcb = (unsigned)(size_t)(LC_OF(dd) + o * 64 + o); asm volatile("" : "+v"(lcb));
        const LAS float* Lcv = (const LAS float*)lcb;
        typedef float f32x2 __attribute__((ext_vector_type(2)));
        const int c = lane & 31, hh = lane >> 5;
        f32x2 x2[16];
#pragma unroll
        for (int m = 0; m < 16; ++m) x2[m] = (f32x2){(2 * m == c) ? 1.f : 0.f, (2 * m + 1 == c) ? 1.f : 0.f};
        float xprev = 0.f;
#pragma unroll
        for (int j = 0; j < 31; ++j) {
            const float xj = (j & 1) ? x2[j >> 1].y : x2[j >> 1].x; const f32x2 xjj = (f32x2){xj, xj};
            unsigned bj = lcb; asm volatile("" : "+v"(bj) : "v"(j ? xprev : xj)); const LAS float* Lj = (const LAS float*)bj; (void)Lcv;
            xprev = xj;
#pragma unroll
            for (int i4 = ((j + 1) & ~3); i4 < 32; i4 += 4) {
                const f32x4 l = *(const LAS f32x4*)(Lj + j * 64 + i4);
                x2[i4 >> 1] -= (f32x2){l.x, l.y} * xjj; x2[(i4 >> 1) + 1] -= (f32x2){l.z, l.w} * xjj;
            }
        }
        const int cdir = o + c, tc = dd ? 63 - cdir : cdir;
        const float bc = vbeta[cdir], bg = bc * __expf(vgc[cdir]);
        if (hh == 0) {
#pragma unroll
            for (int m = 0; m < 16; ++m) {
                TB[(o + 2 * m) * 72 + tc] = (bf16_t)f2bf(x2[m].x * bc); TBG[(o + 2 * m) * 72 + tc] = (bf16_t)f2bf(x2[m].x * bg);
                TB[(o + 2 * m + 1) * 72 + tc] = (bf16_t)f2bf(x2[m].y * bc); TBG[(o + 2 * m + 1) * 72 + tc] = (bf16_t)f2bf(x2[m].y * bg);
            }
            if (blk == 0) {
                LAS bf16_t* ai = AINVT_OF(dd) + c * 40;
#pragma unroll
                for (int q = 0; q < 4; ++q) { u32x4 w; w.x = cvt_pk_bf16(x2[4 * q].x, x2[4 * q].y); w.y = cvt_pk_bf16(x2[4 * q + 1].x, x2[4 * q + 1].y); w.z = cvt_pk_bf16(x2[4 * q + 2].x, x2[4 * q + 2].y); w.w = cvt_pk_bf16(x2[4 * q + 3].x, x2[4 * q + 3].y); *(LAS u32x4*)(ai + 8 * q) = w; }
            } else {
                LAS bf16_t* bi = BINVR_OF(dd) + c;
#pragma unroll
                for (int m = 0; m < 16; ++m) { bi[(2 * m) * 40] = (bf16_t)f2bf(x2[m].x); bi[(2 * m + 1) * 40] = (bf16_t)f2bf(x2[m].y); }
            }
        } else if (blk == 0) {
            const int cz = 32 + c, tz = dd ? 63 - cz : cz;
#pragma unroll
            for (int i = 0; i < 32; ++i) { TB[i * 72 + tz] = (bf16_t)0; TBG[i * 72 + tz] = (bf16_t)0; }
        }
    } else {
        const int t2 = tid - 256;
#pragma unroll
        for (int dd = 0; dd < 2; ++dd) {
            const LAS float* Lc = LC_OF(dd); LAS bf16_t* cr = CR_OF(dd);
#pragma unroll
            for (int e = 0; e < 4; ++e) { const int idx = t2 + 256 * e, k = idx >> 5, i = idx & 31; cr[i * 40 + k] = (bf16_t)f2bf(Lc[k * 64 + 32 + i]); }
        }
#pragma unroll
        for (int dd = 0; dd < 2; ++dd) {
            const LAS float* vgc = VGC_OF(dd); const float gl = vgc[63];
            unsigned char* item = p.ws + OFF_PREP + SLOT_OF(dd) * PREP_STRIDE;
            if (is_lat) {
                unsigned* oqk = (unsigned*)(item + PI_QK);
                for (int idx = t2; idx < 2048; idx += 256) {
                    const int i = idx >> 5, j0 = (idx & 31) * 2, ti = dd ? 63 - i : i;
                    const int tj0 = dd ? 63 - j0 : j0, tj1 = dd ? 62 - j0 : j0 + 1;
                    const float v0 = (i >= j0) ? QKf[ti * 65 + tj0] * __expf(vgc[i] - vgc[j0]) : 0.f;
                    const float v1 = (i >= j0 + 1) ? QKf[ti * 65 + tj1] * __expf(vgc[i] - vgc[j0 + 1]) : 0.f;
                    oqk[idx] = cvt_pk_bf16(v0, v1);
                }
                u32x4* oqd = (u32x4*)(item + PI_QD);
                for (int idx = t2; idx < 1024; idx += 256) {
                    const int i = idx >> 4, c8 = idx & 15, ti = dd ? 63 - i : i; const float eg = __expf(vgc[i]);
                    const u32x4 q = *(const LAS u32x4*)(Qn + ti * 136 + c8 * 8); u32x4 o;
                    o.x = cvt_pk_bf16(bflo(q.x) * eg, bfhi(q.x) * eg); o.y = cvt_pk_bf16(bflo(q.y) * eg, bfhi(q.y) * eg);
                    o.z = cvt_pk_bf16(bflo(q.z) * eg, bfhi(q.z) * eg); o.w = cvt_pk_bf16(bflo(q.w) * eg, bfhi(q.w) * eg);
                    oqd[idx] = o;
                }
            }
            u32x4* okd = (u32x4*)(item + PI_KDT);
            for (int idx = t2; idx < 1024; idx += 256) {
                const int dk = idx >> 3, j8 = idx & 7, tmin = dd ? 56 - j8 * 8 : j8 * 8;
                const u32x4 kq = *(const LAS u32x4*)(KT + dk * 72 + tmin);
                float e[8] = {bflo(kq.x), bfhi(kq.x), bflo(kq.y), bfhi(kq.y), bflo(kq.z), bfhi(kq.z), bflo(kq.w), bfhi(kq.w)};
                float r[8];
#pragma unroll
                for (int jj = 0; jj < 8; ++jj) r[jj] = (dd ? e[7 - jj] : e[jj]) * __expf(gl - vgc[j8 * 8 + jj]);
                u32x4 o; o.x = cvt_pk_bf16(r[0], r[1]); o.y = cvt_pk_bf16(r[2], r[3]); o.z = cvt_pk_bf16(r[4], r[5]); o.w = cvt_pk_bf16(r[6], r[7]);
                okd[idx] = o;
            }
            if (t2 == 0) *(float*)(item + PI_GL) = __expf(gl);
        }
    }
    __syncthreads();
    if (wid == 0 || wid == 2) {
        typedef float f32x16 __attribute__((ext_vector_type(16)));
        const int dd = __builtin_amdgcn_readfirstlane(wid) >> 1, r = lane & 31, hh = lane >> 5;
        const LAS float* vgc = VGC_OF(dd); const LAS float* vbeta = vgc + 64;
        LAS bf16_t* TB = TB_OF(dd); LAS bf16_t* TBG = TBG_OF(dd);
        f32x16 Y, M;
#pragma unroll
        for (int x = 0; x < 16; ++x) { Y[x] = 0.f; M[x] = 0.f; }
#pragma unroll
        for (int sx = 0; sx < 2; ++sx)
            Y = __builtin_amdgcn_mfma_f32_32x32x16_bf16(*(const LAS bf16x8*)(CR_OF(dd) + r * 40 + 16 * sx + 8 * hh), *(const LAS bf16x8*)(AINVT_OF(dd) + r * 40 + 16 * sx + 8 * hh), Y, 0, 0, 0);
#pragma unroll
        for (int sx = 0; sx < 2; ++sx) {
            u32x4 yb; yb.x = cvt_pk_bf16(Y[8 * sx], Y[8 * sx + 1]); yb.y = cvt_pk_bf16(Y[8 * sx + 2], Y[8 * sx + 3]); yb.z = cvt_pk_bf16(Y[8 * sx + 4], Y[8 * sx + 5]); yb.w = cvt_pk_bf16(Y[8 * sx + 6], Y[8 * sx + 7]);
            const u32x2 lo = *(const LAS u32x2*)(BINVR_OF(dd) + r * 40 + 16 * sx + 4 * hh), hi = *(const LAS u32x2*)(BINVR_OF(dd) + r * 40 + 16 * sx + 8 + 4 * hh);
            u32x4 pa; pa.x = lo.x; pa.y = lo.y; pa.z = hi.x; pa.w = hi.y;
            M = __builtin_amdgcn_mfma_f32_32x32x16_bf16(__builtin_bit_cast(bf16x8, pa), __builtin_bit_cast(bf16x8, yb), M, 0, 0, 0);
        }
        const int tc = dd ? 63 - r : r; const float bc = vbeta[r], bg = bc * __expf(vgc[r]);
#pragma unroll
        for (int x = 0; x < 16; ++x) {
            const int i = 32 + (x & 3) + 8 * (x >> 2) + 4 * hh;
            TB[i * 72 + tc] = (bf16_t)f2bf(-M[x] * bc); TBG[i * 72 + tc] = (bf16_t)f2bf(-M[x] * bg);
        }
    }
    __syncthreads();
#undef AINVT_OF
#undef BINVR_OF
#undef CR_OF
    {
        const int dd = __builtin_amdgcn_readfirstlane(wid) >> 2, mat = (wid >> 1) & 1;
        const LAS bf16_t* Am = mat ? TBG_OF(dd) : TB_OF(dd); const LAS bf16_t* Bm = mat ? KT : VT;
        LAS bf16_t* img = (LAS bf16_t*)(L + (dd ? PL_KK : PL_QN) + mat * 17408); const float sgn = mat ? -1.f : 1.f;
#pragma unroll
        for (int th = 0; th < 2; ++th) {
            const int ti = (wid & 1) * 2 + th;
            const bf16x8 a0 = *(const LAS bf16x8*)(Am + (ti * 16 + fr) * 72 + fq * 8), a1 = *(const LAS bf16x8*)(Am + (ti * 16 + fr) * 72 + 32 + fq * 8);
#pragma unroll
            for (int tn = 0; tn < 8; ++tn) {
                f32x4 acc = (f32x4){0.f, 0.f, 0.f, 0.f};
                acc = MFMA16(a0, *(const LAS bf16x8*)(Bm + (tn * 16 + fr) * 72 + fq * 8), acc);
                acc = MFMA16(a1, *(const LAS bf16x8*)(Bm + (tn * 16 + fr) * 72 + 32 + fq * 8), acc);
#pragma unroll
                for (int j = 0; j < 4; ++j) img[(ti * 16 + fq * 4 + j) * 136 + tn * 16 + fr] = (bf16_t)f2bf(acc[j] * sgn);
            }
        }
    }
    __syncthreads();
#pragma unroll
    for (int e = 0; e < 8; ++e) {
        const int idx = tid + NT * e, dd = idx >> 11, mat = (idx >> 10) & 1, row = (idx >> 4) & 63, cq = idx & 15;
        const u32x4 v = *(const LAS u32x4*)((const LAS bf16_t*)(L + (dd ? PL_KK : PL_QN) + mat * 17408) + row * 136 + cq * 8);
        *(u32x4*)(p.ws + OFF_PREP + SLOT_OF(dd) * PREP_STRIDE + (mat ? PI_W : PI_U) + row * 256 + cq * 16) = v;
    }
    __syncthreads();
#undef SLOT_OF
#undef LC_OF
#undef TB_OF
#undef TBG_OF
#undef VGC_OF
}

DI void chunk_mlp_item(const Params& p, LAS unsigned char* L, int b, int n, int g) {
    int tid_ = threadIdx.x; asm volatile("" : "+v"(tid_));
    const int tid = tid_, lane = tid & 63, wid = tid >> 6, fr = lane & 15, fq = lane >> 4;
    LAS bf16_t* SW = (LAS bf16_t*)L; LAS bf16_t* VNT = (LAS bf16_t*)(L + 34816);
    const int row0 = b * 2048 + n * 128;
    {
        const int pr = tid >> 2, part = tid & 3;
        const float* sw = p.spatial_w + ((size_t)g * 128 + pr) * 128 + part * 32;
#pragma unroll
        for (int i = 0; i < 4; ++i) {
            const f32x4 a = *(const f32x4*)(sw + i * 8), c = *(const f32x4*)(sw + i * 8 + 4);
            u32x4 w; w.x = cvt_pk_bf16(a.x, a.y); w.y = cvt_pk_bf16(a.z, a.w); w.z = cvt_pk_bf16(c.x, c.y); w.w = cvt_pk_bf16(c.z, c.w);
            *(LAS u32x4*)(SW + pr * 136 + part * 32 + i * 8) = w;
        }
        const bf16_t* zv = (const bf16_t*)(p.ws + OFF_ZV) + (size_t)(row0 + pr) * 1024 + g * 128 + part * 32;
        float v[32]; float ss = 0.f;
#pragma unroll
        for (int i = 0; i < 4; ++i) {
            const u32x4 q = *(const u32x4*)(zv + i * 8);
            v[i * 8 + 0] = bflo(q.x); v[i * 8 + 1] = bfhi(q.x); v[i * 8 + 2] = bflo(q.y); v[i * 8 + 3] = bfhi(q.y);
            v[i * 8 + 4] = bflo(q.z); v[i * 8 + 5] = bfhi(q.z); v[i * 8 + 6] = bflo(q.w); v[i * 8 + 7] = bfhi(q.w);
        }
#pragma unroll
        for (int i = 0; i < 32; ++i) ss += v[i] * v[i];
        ss += __shfl_xor(ss, 1); ss += __shfl_xor(ss, 2);
        const float rstd = rsqrtf(ss * (1.0f / 128.0f) + 1e-6f);
        const float* vg = p.mlp_norm_g + g * 128 + part * 32;
#pragma unroll
        for (int i = 0; i < 32; ++i) VNT[(part * 32 + i) * 136 + pr] = (bf16_t)f2bf(v[i] * rstd * vg[i]);
    }
    __syncthreads();
    f32x4 acc[8];
#pragma unroll
    for (int ci = 0; ci < 8; ++ci) acc[ci] = (f32x4){0.f, 0.f, 0.f, 0.f};
#pragma unroll
    for (int k = 0; k < 4; ++k) {
        const bf16x8 a = *(const LAS bf16x8*)(SW + (wid * 16 + fr) * 136 + k * 32 + fq * 8);
#pragma unroll
        for (int ci = 0; ci < 8; ++ci) acc[ci] = MFMA16(a, *(const LAS bf16x8*)(VNT + (ci * 16 + fr) * 136 + k * 32 + fq * 8), acc[ci]);
    }
    LAS float* Sf = (LAS float*)(L + 69632);
#pragma unroll
    for (int j = 0; j < 4; ++j) {
        const int pp = wid * 16 + fq * 4 + j; const float bs = p.spatial_b[g * 128 + pp];
#pragma unroll
        for (int ci = 0; ci < 8; ++ci) Sf[pp * 132 + ci * 16 + fr] = acc[ci][j] + bs;
    }
    __syncthreads();
    const bf16_t* ZU = (const bf16_t*)(p.ws + OFF_ZU); bf16_t* O = (bf16_t*)(p.ws + OFF_O);
#pragma unroll
    for (int e = 0; e < 4; ++e) {
        const int idx = tid + NT * e, pp = idx >> 4, c8 = idx & 15; const size_t row = row0 + pp;
        const u32x4 zu = *(const u32x4*)(ZU + row * 1024 + g * 128 + c8 * 8);
        const f32x4 s0 = *(const LAS f32x4*)(Sf + pp * 132 + c8 * 8), s1 = *(const LAS f32x4*)(Sf + pp * 132 + c8 * 8 + 4);
        u32x4 o; o.x = cvt_pk_bf16(bflo(zu.x) * s0.x, bfhi(zu.x) * s0.y); o.y = cvt_pk_bf16(bflo(zu.y) * s0.z, bfhi(zu.y) * s0.w);
        o.z = cvt_pk_bf16(bflo(zu.z) * s1.x, bfhi(zu.z) * s1.y); o.w = cvt_pk_bf16(bflo(zu.w) * s1.z, bfhi(zu.w) * s1.w);
        *(u32x4*)(O + row * D + 1024 + g * 128 + c8 * 8) = o;
    }
    __syncthreads();
}

constexpr int SL_W = 0, SL_QD = 17408, SL_KDT = 34816, SL_QK = 53248, SL_ST = 62464, SL_VN = 71168;
DI void dn_scan(const Params& p, LAS unsigned char* L, int ch, int round) {
    int tid_ = threadIdx.x; asm volatile("" : "+v"(tid_));
    const int tid = tid_, lane = tid & 63, wid = tid >> 6, fr = lane & 15, fq = lane >> 4;
    const int eq = ch & 3, d = (ch >> 2) & 1, h = (ch >> 3) & 7, bl = ch >> 6, b = round * 4 + bl;
    LAS bf16_t* Wl = (LAS bf16_t*)(L + SL_W); LAS bf16_t* QDl = (LAS bf16_t*)(L + SL_QD); LAS bf16_t* KDTl = (LAS bf16_t*)(L + SL_KDT);
    LAS bf16_t* QKl = (LAS bf16_t*)(L + SL_QK); LAS bf16_t* STl = (LAS bf16_t*)(L + SL_ST); LAS bf16_t* VNl = (LAS bf16_t*)(L + SL_VN);
    f32x4 S[2];
#pragma unroll
    for (int n2 = 0; n2 < 2; ++n2) S[n2] = (f32x4){0.f, 0.f, 0.f, 0.f};
    const int mi = wid >> 1, ni = wid & 1;
    const unsigned char* item0 = p.ws + OFF_PREP + (size_t)((((bl * 8 + h) * 2 + d) * 36)) * PREP_STRIDE;
    u32x4 rW[2][2], rQD[2][2], rKD[2][2], rQK[2]; bf16_t nU[4]; float nGL;
    int vz = 0; asm volatile("" : "+v"(vz));
#define SCAN_LOAD(P, it) do { const unsigned char* _p = (it); \
        rW[P][0] = *(const u32x4*)(_p + PI_W + tid * 16); rW[P][1] = *(const u32x4*)(_p + PI_W + (tid + NT) * 16); \
        rQD[P][0] = *(const u32x4*)(_p + PI_QD + tid * 16); rQD[P][1] = *(const u32x4*)(_p + PI_QD + (tid + NT) * 16); \
        rKD[P][0] = *(const u32x4*)(_p + PI_KDT + tid * 16); rKD[P][1] = *(const u32x4*)(_p + PI_KDT + (tid + NT) * 16); \
        rQK[P] = *(const u32x4*)(_p + PI_QK + tid * 16); } while (0)
#define SCAN_LOADU(it) do { const unsigned char* _p = (it); nGL = *(const float*)(_p + PI_GL + vz); \
        _Pragma("unroll") for (int _j = 0; _j < 4; ++_j) \
            nU[_j] = ((const bf16_t*)(_p + PI_U))[(mi * 16 + fq * 4 + _j) * 128 + eq * 32 + ni * 16 + fr]; } while (0)
#define SCAN_STORE_A(P) do { \
        _Pragma("unroll") for (int _i = 0; _i < 2; ++_i) { const int _x = tid + _i * NT; \
            *(LAS u32x4*)(Wl + (_x >> 4) * 136 + (_x & 15) * 8) = rW[P][_i]; *(LAS u32x4*)(QDl + (_x >> 4) * 136 + (_x & 15) * 8) = rQD[P][_i]; } } while (0)
#define SCAN_STORE_B(P) do { \
        _Pragma("unroll") for (int _i = 0; _i < 2; ++_i) { const int _x = tid + _i * NT; \
            *(LAS u32x4*)(KDTl + (_x >> 3) * 72 + (_x & 7) * 8) = rKD[P][_i]; } \
        *(LAS u32x4*)(QKl + (tid >> 3) * 72 + (tid & 7) * 8) = rQK[P]; } while (0)
    SCAN_LOADU(item0);
    SCAN_LOAD(0, item0);
    SCAN_LOAD(1, item0 + PREP_STRIDE);
#pragma unroll
    for (int n2 = 0; n2 < 2; ++n2) { u32x2 w; w.x = cvt_pk_bf16(S[n2][0], S[n2][1]); w.y = cvt_pk_bf16(S[n2][2], S[n2][3]); *(LAS u32x2*)(STl + (n2 * 16 + fr) * 136 + wid * 16 + fq * 4) = w; }
    SCAN_STORE_A(0); SCAN_STORE_B(0);
    __syncthreads();
    for (int s2 = 0; s2 < NSTEP; s2 += 2) {
#pragma unroll
      for (int par = 0; par < 2; ++par) {
        const int s = s2 + par;
        f32x4 vacc = (f32x4){bf2f(nU[0]), bf2f(nU[1]), bf2f(nU[2]), bf2f(nU[3])}; const float gl = nGL;
        if (s + 1 < NSTEP) SCAN_LOADU(item0 + (size_t)(s + 1) * PREP_STRIDE);
        if (s + 2 < NSTEP) SCAN_LOAD(par, item0 + (size_t)(s + 2) * PREP_STRIDE);
        f32x4 oacc = (f32x4){0.f, 0.f, 0.f, 0.f};
#pragma unroll
        for (int k = 0; k < 4; ++k) {
            const bf16x8 sb = *(const LAS bf16x8*)(STl + (ni * 16 + fr) * 136 + k * 32 + fq * 8);
            vacc = MFMA16(*(const LAS bf16x8*)(Wl + (mi * 16 + fr) * 136 + k * 32 + fq * 8), sb, vacc);
            if (s >= 4) oacc = MFMA16(*(const LAS bf16x8*)(QDl + (mi * 16 + fr) * 136 + k * 32 + fq * 8), sb, oacc);
        }
        { u32x2 w; w.x = cvt_pk_bf16(vacc[0], vacc[1]); w.y = cvt_pk_bf16(vacc[2], vacc[3]); *(LAS u32x2*)(VNl + (ni * 16 + fr) * 72 + mi * 16 + fq * 4) = w; }
        __syncthreads();
        if (s >= 4) {
#pragma unroll
            for (int k = 0; k < 2; ++k)
                oacc = MFMA16(*(const LAS bf16x8*)(QKl + (mi * 16 + fr) * 72 + k * 32 + fq * 8), *(const LAS bf16x8*)(VNl + (ni * 16 + fr) * 72 + k * 32 + fq * 8), oacc);
            const int lc = d ? 31 - (s - 4) : (s - 4);
            bf16_t* od = (bf16_t*)(p.ws + OFF_ODIR) + (size_t)d * MX * 1024;
#pragma unroll
            for (int j = 0; j < 4; ++j) {
                const int i = mi * 16 + fq * 4 + j, tok = d ? 63 - i : i; const size_t row = (size_t)b * 2048 + lc * 64 + tok;
                od[row * 1024 + h * 128 + eq * 32 + ni * 16 + fr] = (bf16_t)f2bf(oacc[j]);
            }
        }
#pragma unroll
        for (int n2 = 0; n2 < 2; ++n2) S[n2] *= gl;
#pragma unroll
        for (int k = 0; k < 2; ++k) {
            const bf16x8 a = *(const LAS bf16x8*)(KDTl + (wid * 16 + fr) * 72 + k * 32 + fq * 8);
#pragma unroll
            for (int n2 = 0; n2 < 2; ++n2) S[n2] = MFMA16(a, *(const LAS bf16x8*)(VNl + (n2 * 16 + fr) * 72 + k * 32 + fq * 8), S[n2]);
        }
#pragma unroll
        for (int n2 = 0; n2 < 2; ++n2) { u32x2 w; w.x = cvt_pk_bf16(S[n2][0], S[n2][1]); w.y = cvt_pk_bf16(S[n2][2], S[n2][3]); *(LAS u32x2*)(STl + (n2 * 16 + fr) * 136 + wid * 16 + fq * 4) = w; }
        if (s + 1 < NSTEP) SCAN_STORE_A(par ^ 1);
        __syncthreads();
        if (s + 1 < NSTEP) SCAN_STORE_B(par ^ 1);
      }
    }
#undef SCAN_LOAD
#undef SCAN_LOADU
#undef SCAN_STORE_A
#undef SCAN_STORE_B
}

DI void combine_phase(const Params& p, int gw, int NGW, int lane) {
    const bf16_t* o0 = (const bf16_t*)(p.ws + OFF_ODIR); const bf16_t* o1 = o0 + (size_t)MX * 1024;
    const bf16_t* zg = (const bf16_t*)(p.ws + OFF_ZG); bf16_t* O = (bf16_t*)(p.ws + OFF_O);
    for (int r = gw; r < MX; r += NGW) {
        const size_t off = (size_t)r * 1024 + lane * 16;
        float v[16], gt[16]; float ss = 0.f;
#pragma unroll
        for (int i = 0; i < 2; ++i) {
            const u32x4 a = *(const u32x4*)(o0 + off + i * 8), c = *(const u32x4*)(o1 + off + i * 8), g = *(const u32x4*)(zg + off + i * 8);
            v[i * 8 + 0] = bflo(a.x) + bflo(c.x); v[i * 8 + 1] = bfhi(a.x) + bfhi(c.x); v[i * 8 + 2] = bflo(a.y) + bflo(c.y); v[i * 8 + 3] = bfhi(a.y) + bfhi(c.y);
            v[i * 8 + 4] = bflo(a.z) + bflo(c.z); v[i * 8 + 5] = bfhi(a.z) + bfhi(c.z); v[i * 8 + 6] = bflo(a.w) + bflo(c.w); v[i * 8 + 7] = bfhi(a.w) + bfhi(c.w);
            gt[i * 8 + 0] = bflo(g.x); gt[i * 8 + 1] = bfhi(g.x); gt[i * 8 + 2] = bflo(g.y); gt[i * 8 + 3] = bfhi(g.y);
            gt[i * 8 + 4] = bflo(g.z); gt[i * 8 + 5] = bfhi(g.z); gt[i * 8 + 6] = bflo(g.w); gt[i * 8 + 7] = bfhi(g.w);
        }
#pragma unroll
        for (int i = 0; i < 16; ++i) ss += v[i] * v[i];
        ss += __shfl_xor(ss, 1); ss += __shfl_xor(ss, 2); ss += __shfl_xor(ss, 4);
        const float rstd = rsqrtf(ss * (1.0f / 128.0f) + 1e-6f);
        const float* hg = p.head_norm_g + (lane & 7) * 16;
        float y[16];
#pragma unroll
        for (int i = 0; i < 16; ++i) y[i] = v[i] * rstd * hg[i] * gt[i];
        u32x4 w0, w1;
        w0.x = cvt_pk_bf16(y[0], y[1]); w0.y = cvt_pk_bf16(y[2], y[3]); w0.z = cvt_pk_bf16(y[4], y[5]); w0.w = cvt_pk_bf16(y[6], y[7]);
        w1.x = cvt_pk_bf16(y[8], y[9]); w1.y = cvt_pk_bf16(y[10], y[11]); w1.z = cvt_pk_bf16(y[12], y[13]); w1.w = cvt_pk_bf16(y[14], y[15]);
        bf16_t* op = O + (size_t)r * D + lane * 16;
        *(u32x4*)op = w0; *(u32x4*)(op + 8) = w1;
    }
}

#define XB_TMO      128
#define XB_XCNT(j)  (256  + 64 * (j))
#define XB_XSUB(j)  (1280 + 64 * (j))
#define XB_XGEN(j)  (2304 + 64 * (j))
#define XB_TOP      3328
#define XB_TOPGEN   3392
#define XCD_BAR_WORDS 3456
#define XB_SPIN_CAP (1u << 18)

__device__ __forceinline__ unsigned xb_ld(unsigned* p)              { return __hip_atomic_load(p, __ATOMIC_RELAXED, __HIP_MEMORY_SCOPE_AGENT); }
__device__ __forceinline__ unsigned xb_add(unsigned* p, unsigned v) { return __hip_atomic_fetch_add(p, v, __ATOMIC_RELAXED, __HIP_MEMORY_SCOPE_AGENT); }
__device__ __forceinline__ unsigned xb_xcc_id() { return (unsigned)__builtin_amdgcn_s_getreg((3 << 11) | 20) & 0xFu; }
#define XB_SPIN(cond, bar) do { unsigned _sp = 0; while (cond) { __builtin_amdgcn_s_sleep(1); \
    if ((++_sp & 255u) == 0u) { if (xb_ld(&(bar)[XB_TMO])) break; if (_sp > XB_SPIN_CAP) { atomicAdd(&(bar)[XB_TMO], 1u); break; } } } } while (0)

struct XcdBarrier {
    unsigned* bar; unsigned x;
    volatile LAS unsigned* st;
};

__device__ __forceinline__ XcdBarrier xcd_barrier_post(unsigned* bar, volatile LAS unsigned* st) {
    XcdBarrier b; b.bar = bar; b.x = xb_xcc_id(); b.st = st;
    if (threadIdx.x == 0) (void)xb_add(&bar[XB_XCNT(b.x)], 1u);
    return b;
}
__device__ __forceinline__ void xcd_barrier_complete(unsigned* bar, unsigned x, unsigned& nloc, unsigned& nx) {
    const unsigned G = gridDim.x * gridDim.y * gridDim.z;
    unsigned sum, cnt, mine, sp = 0u;
    for (;;) {
        sum = 0u; cnt = 0u; mine = 0u;
#pragma unroll
        for (unsigned j = 0; j < 16; ++j) { const unsigned c = xb_ld(&bar[XB_XCNT(j)]); sum += c; cnt += (c > 0u) ? 1u : 0u; mine = (j == x) ? c : mine; }
        if (sum == G) break;
        __builtin_amdgcn_s_sleep(1);
        if ((++sp & 255u) == 0u) { if (xb_ld(&bar[XB_TMO])) break; if (sp > XB_SPIN_CAP) { atomicAdd(&bar[XB_TMO], 1u); break; } }
    }
    nloc = mine > 0u ? mine : 1u; nx = cnt > 0u ? cnt : 1u;
}

__device__ __forceinline__ void xcd_barrier(const XcdBarrier& b) {
    asm volatile("s_waitcnt vmcnt(0)" ::: "memory");
    __syncthreads();
    if (threadIdx.x == 0) {
        unsigned* bar = b.bar;
        __builtin_amdgcn_s_waitcnt(0);
        unsigned nloc = b.st[0], nx = b.st[1];
        if (nloc == 0u) { xcd_barrier_complete(bar, b.x, nloc, nx); b.st[0] = nloc; b.st[1] = nx; }
        const unsigned old = xb_add(&bar[XB_XSUB(b.x)], 1u);
        const unsigned gen = old / nloc;
        if (old + 1u == (gen + 1u) * nloc) {
            __builtin_amdgcn_fence(__ATOMIC_RELEASE, "agent");
            asm volatile("s_waitcnt vmcnt(0)" ::: "memory");
            const unsigned og = xb_add(&bar[XB_TOP], 1u);
            const unsigned tg = og / nx;
            if (og + 1u == (tg + 1u) * nx) xb_add(&bar[XB_TOPGEN], 1u);
            else XB_SPIN(xb_ld(&bar[XB_TOPGEN]) == tg, bar);
            __builtin_amdgcn_fence(__ATOMIC_ACQUIRE, "agent");
            xb_add(&bar[XB_XGEN(b.x)], 1u);
            asm volatile("s_waitcnt vmcnt(0)" ::: "memory");
        } else {
            XB_SPIN(xb_ld(&bar[XB_XGEN(b.x)]) == gen, bar);
            __builtin_amdgcn_fence(__ATOMIC_ACQUIRE, "agent");
            asm volatile("s_waitcnt vmcnt(0)" ::: "memory");
        }
    }
    __syncthreads();
}

DI void fast_gsync(unsigned* bar, unsigned target) {
    asm volatile("s_waitcnt vmcnt(0)" ::: "memory");
    __syncthreads();
    if (threadIdx.x == 0) {
        __builtin_amdgcn_fence(__ATOMIC_RELEASE, "agent");
        asm volatile("s_waitcnt vmcnt(0)" ::: "memory");
        __hip_atomic_fetch_add(bar, 1u, __ATOMIC_RELAXED, __HIP_MEMORY_SCOPE_AGENT);
        while (__hip_atomic_load(bar, __ATOMIC_RELAXED, __HIP_MEMORY_SCOPE_AGENT) < target) __builtin_amdgcn_s_sleep(1);
        __builtin_amdgcn_fence(__ATOMIC_ACQUIRE, "agent");
        asm volatile("s_waitcnt vmcnt(0)" ::: "memory");
    }
    __syncthreads();
}
template <class Epi> DI void run_gemm(LAS unsigned char* L, const bf16_t* A, const bf16_t* Bt, int M, int N, int K, const Epi& E) {
    pg8::Gemm g{A, Bt, M, N, K}; pg8::StaticOrder S; S.init(M, N, (int)gridDim.x, (int)blockIdx.x);
    pg8::gemm_phase<Epi, pg8::StaticOrder, false>(L, g, S, E, nullptr);
    __syncthreads();
}

struct InprojOrder {
    int G, c;
    DI bool next(int i, Unit& u) const {
        const int Lx = i * G + c; if (Lx >= 1704) return false;
        if (Lx < 1600) { const int wgid = (Lx % 8) * 200 + Lx / 8; const int gid = wgid / 200, rem = wgid % 200; u.pm = gid * 8 + (rem % 8); u.pn = rem / 8; }
        else { const int l2 = Lx - 1600, q = l2 % 13; u.pm = 64 + l2 / 13; u.pn = q < 12 ? q : 24; }
        return true;
    }
    DI void a_ready(const Unit&) const {}
    DI void done(const Unit&) const {}
};
struct FfnUpOrder {
    int c;
    DI bool next(int i, Unit& u) const {
        const int xcd = c & 7, slot = c >> 3, j = i * 32 + slot;
        if (j >= 387) return false;
        if (j < 344) { u.pm = xcd * 8 + (j & 7); u.pn = j >> 3; }
        else { const int q = xcd * 43 + (j - 344); u.pm = 64 + (q & 7); u.pn = q >> 3; }
        return true;
    }
    DI void a_ready(const Unit&) const {}
    DI void done(const Unit&) const {}
};
__global__ void __launch_bounds__(NT, 2) fwd_megakernel(Params p_unused) {
    extern __shared__ __attribute__((aligned(16))) unsigned char lds_raw[];
    LAS unsigned char* L = (LAS unsigned char*)lds_raw;
    cg::grid_group grid = cg::this_grid();
#define GSYNC_CG() do { __builtin_amdgcn_fence(__ATOMIC_RELEASE, "agent"); grid.sync(); __builtin_amdgcn_fence(__ATOMIC_ACQUIRE, "agent"); } while (0)
    XcdBarrier xbar;
    { volatile LAS unsigned* st = (volatile LAS unsigned*)(L + 159488);
      if (threadIdx.x < 2) st[threadIdx.x] = 0u;
      __syncthreads();
      const Params pb_ = load_params();
      xbar = xcd_barrier_post((unsigned*)(pb_.ws + OFF_BAR), st); }
#define GSYNC() do { if (gridDim.x == 256) xcd_barrier(xbar); else GSYNC_CG(); } while (0)
#define TIDS const int tid = threadIdx.x, lane = tid & 63, wid = __builtin_amdgcn_readfirstlane(tid >> 6); const int G = gridDim.x, bid = blockIdx.x, gw = bid * 8 + wid, NGW = G * 8; (void)lane; (void)gw; (void)NGW; (void)G; (void)bid
    { TIDS; const Params p = load_params();
      mod_gemv(p, L, bid, G);
      if (G == 256) { if (bid >= 32) convert_weights(p.ffn1_w_in, D, NUP, NUP, 1, (bf16_t*)(p.ws + OFF_WT_FFN_IN), L, (bid - 32) * 8 + wid, 224 * 8, wid, lane); }
      else convert_weights(p.ffn1_w_in, D, NUP, NUP, 1, (bf16_t*)(p.ws + OFF_WT_FFN_IN), L, gw, NGW, wid, lane);
      if (G != 256) {
          convert_weights(p.ffn1_w_out, FF, D, D, 0, (bf16_t*)(p.ws + OFF_WT_FFN_OUT), L, gw, NGW, wid, lane);
          convert_weights(p.w_in, D, 6176, NIN, 2, (bf16_t*)(p.ws + OFF_WT_IN), L, gw, NGW, wid, lane);
          convert_weights(p.w_out, D, D, D, 0, (bf16_t*)(p.ws + OFF_WT_OUT), L, gw, NGW, wid, lane);
      } }
    GSYNC();
    { TIDS; const Params p = load_params();
      if (G == 256) {
          norm_mod_batched(p.x, p.norm_g, (const float*)(p.ws + OFF_MOD), 0, (bf16_t*)(p.ws + OFF_H), L, bid, 256, wid, lane);
          norm_mod_phase(p.x, p.ctx, MX, MALL, p.norm_g, (const float*)(p.ws + OFF_MOD), 0, (bf16_t*)(p.ws + OFF_H), gw, NGW, lane);
      } else norm_mod_phase(p.x, p.ctx, 0, MALL, p.norm_g, (const float*)(p.ws + OFF_MOD), 0, (bf16_t*)(p.ws + OFF_H), gw, NGW, lane); }
    GSYNC();
    { const Params p = load_params();
      if (gridDim.x == 256) {
          pg8::Gemm g{(const bf16_t*)(p.ws + OFF_H), (const bf16_t*)(p.ws + OFF_WT_FFN_IN), MALL, NUP, D}; const FfnUpOrder S{(int)blockIdx.x}; const EpiSwiglu E{(bf16_t*)(p.ws + OFF_G)};
          pg8::gemm_phase<EpiSwiglu, FfnUpOrder, false>(L, g, S, E, nullptr);
          __syncthreads();
      } else run_gemm(L, (const bf16_t*)(p.ws + OFF_H), (const bf16_t*)(p.ws + OFF_WT_FFN_IN), MALL, NUP, D, EpiSwiglu{(bf16_t*)(p.ws + OFF_G)});
      if (gridDim.x == 256 && blockIdx.x >= 24) { TIDS;
          convert_weights(p.ffn1_w_out, FF, D, D, 0, (bf16_t*)(p.ws + OFF_WT_FFN_OUT), L, (bid - 24) * 8 + wid, 232 * 8, wid, lane);
          convert_weights(p.w_in, D, 6176, NIN, 2, (bf16_t*)(p.ws + OFF_WT_IN), L, (bid - 24) * 8 + wid, 232 * 8, wid, lane);
          convert_weights(p.w_out, D, D, D, 0, (bf16_t*)(p.ws + OFF_WT_OUT), L, (bid - 24) * 8 + wid, 232 * 8, wid, lane); } }
    GSYNC();
    { const Params p = load_params();
      run_gemm(L, (const bf16_t*)(p.ws + OFF_G), (const bf16_t*)(p.ws + OFF_WT_FFN_OUT), MX, D, FF, EpiResid{p.x, p.ctx, p.out, (float*)(p.ws + OFF_CTX1), (const float*)(p.ws + OFF_MOD), 2, 0.5f, 0}); }
    GSYNC();
    { TIDS; const Params p = load_params();
      if (G == 256) {
          float* Pp = (float*)(p.ws + OFF_CTX1);
          if (bid < 128) {
              const int half = bid >> 6, koff = half ? 2816 : 0;
              pg8::Gemm g{(const bf16_t*)(p.ws + OFF_G) + (size_t)MX * FF + koff, (const bf16_t*)(p.ws + OFF_WT_FFN_OUT) + koff, MC, D, half ? 2688 : 2816, FF};
              pg8::StaticOrder S; S.init(MC, D, 64, bid & 63);
              const EpiPartial E{Pp + (size_t)half * MC * D};
              pg8::gemm_phase<EpiPartial, pg8::StaticOrder, false>(L, g, S, E, nullptr);
              __syncthreads();
              convert_weights(p.ffn2_w_in, D, NUP, NUP, 1, (bf16_t*)(p.ws + OFF_WT_FFN_IN), L, bid * 8 + wid, 128 * 8, wid, lane, 0, 2);
          } else {
              norm_mod_batched(p.out, p.norm_g + D, (const float*)(p.ws + OFF_MOD), 3, (bf16_t*)(p.ws + OFF_H), L, bid - 128, 128, wid, lane);
              convert_weights(p.ffn2_w_in, D, NUP, NUP, 1, (bf16_t*)(p.ws + OFF_WT_FFN_IN), L, (bid - 128) * 8 + wid, 128 * 8, wid, lane, 1, 2);
          }
      } else if (G >= 128) {
          if (bid < 64) {
              pg8::Gemm g{(const bf16_t*)(p.ws + OFF_G) + (size_t)MX * FF, (const bf16_t*)(p.ws + OFF_WT_FFN_OUT), MC, D, FF}; pg8::StaticOrder S; S.init(MC, D, 64, bid);
              const EpiResid E{p.ctx, p.ctx, (float*)(p.ws + OFF_CTX1), (float*)(p.ws + OFF_CTX1), (const float*)(p.ws + OFF_MOD), 2, 0.5f, 1};
              pg8::gemm_phase<EpiResid, pg8::StaticOrder, false>(L, g, S, E, nullptr);
              __syncthreads();
          } else {
              const int gw2 = (bid - 64) * 8 + wid, NGW2 = (G - 64) * 8;
              if (G == 256) norm_mod_batched(p.out, p.norm_g + D, (const float*)(p.ws + OFF_MOD), 3, (bf16_t*)(p.ws + OFF_H), L, bid - 64, 192, wid, lane);
              else norm_mod_phase(p.out, p.out, 0, MX, p.norm_g + D, (const float*)(p.ws + OFF_MOD), 3, (bf16_t*)(p.ws + OFF_H), gw2, NGW2, lane);
              convert_weights(p.ffn2_w_in, D, NUP, NUP, 1, (bf16_t*)(p.ws + OFF_WT_FFN_IN), L, gw2, NGW2, wid, lane);
          }
      } else {
          run_gemm(L, (const bf16_t*)(p.ws + OFF_G) + (size_t)MX * FF, (const bf16_t*)(p.ws + OFF_WT_FFN_OUT), MC, D, FF, EpiResid{p.ctx, p.ctx, (float*)(p.ws + OFF_CTX1), (float*)(p.ws + OFF_CTX1), (const float*)(p.ws + OFF_MOD), 2, 0.5f, 1});
          norm_mod_phase(p.out, p.out, 0, MX, p.norm_g + D, (const float*)(p.ws + OFF_MOD), 3, (bf16_t*)(p.ws + OFF_H), gw, NGW, lane);
          convert_weights(p.ffn2_w_in, D, NUP, NUP, 1, (bf16_t*)(p.ws + OFF_WT_FFN_IN), L, gw, NGW, wid, lane);
      } }
    GSYNC();
    { TIDS; const Params p = load_params();
      if (G == 256) ctx_norm_from_partials(p.ctx, (const float*)(p.ws + OFF_CTX1), (const float*)(p.ws + OFF_CTX1) + (size_t)MC * D, p.norm_g + D, (const float*)(p.ws + OFF_MOD), (bf16_t*)(p.ws + OFF_H), gw, NGW, lane);
      else norm_mod_phase(p.out, (const float*)(p.ws + OFF_CTX1), MX, MALL, p.norm_g + D, (const float*)(p.ws + OFF_MOD), 3, (bf16_t*)(p.ws + OFF_H), gw, NGW, lane);
      if (G != 256) convert_weights(p.ffn2_w_out, FF, D, D, 0, (bf16_t*)(p.ws + OFF_WT_FFN_OUT), L, gw, NGW, wid, lane); }
    GSYNC();
    { const Params p = load_params();
      pg8::Gemm g{(const bf16_t*)(p.ws + OFF_H), (const bf16_t*)(p.ws + OFF_WT_IN), MALL, NIN, D}; const InprojOrder S{(int)gridDim.x, (int)blockIdx.x};
      const EpiInproj E{p.ws};
      pg8::gemm_phase<EpiInproj, InprojOrder, false>(L, g, S, E, nullptr);
      __syncthreads();
      if (gridDim.x == 256 && blockIdx.x >= 168) { TIDS; convert_weights(p.ffn2_w_out, FF, D, D, 0, (bf16_t*)(p.ws + OFF_WT_FFN_OUT), L, (bid - 168) * 8 + wid, 88 * 8, wid, lane); } }
    GSYNC();
    for (int round = 0; round < NROUND; ++round) {
        { const Params p = load_params(); const int G = gridDim.x, bid = blockIdx.x;
          if (G == 256) {
              for (int it = bid; it < 1152; it += 256) dn_prep_item(p, L, round * 4 + it / 288, (it >> 3) % 36, it & 7);
              if (bid < 128) { const int m = round * 128 + bid; chunk_mlp_item(p, L, m >> 7, (m >> 3) & 15, m & 7); }
              else { for (int q = 0; q < 3; ++q) { const int m = 256 + (round * 3 + q) * 128 + (bid - 128); chunk_mlp_item(p, L, m >> 7, (m >> 3) & 15, m & 7); } }
          } else {
              const int nitems = 1152 + (round == 0 ? 1024 : 0);
              for (int it = bid; it < nitems; it += G) {
                  if (it < 1152) { dn_prep_item(p, L, round * 4 + it / 288, (it >> 3) % 36, it & 7); }
                  else { const int m = it - 1152; chunk_mlp_item(p, L, m >> 7, (m >> 3) & 15, m & 7); }
              }
          } }
        GSYNC();
        { const Params p = load_params(); const int G = gridDim.x, bid = blockIdx.x;
          for (int c0 = bid; c0 < 256; c0 += G) { const int xq = c0 & 7, yq = c0 >> 3, ch = ((xq * 8 + (yq >> 2)) << 2) | (yq & 3); dn_scan(p, L, ch, round); __syncthreads(); } }
        GSYNC();
    }
    { TIDS; const Params p = load_params(); combine_phase(p, gw, NGW, lane); }
    GSYNC();
    { const Params p = load_params();
      run_gemm(L, (const bf16_t*)(p.ws + OFF_O), (const bf16_t*)(p.ws + OFF_WT_OUT), MX, D, D, EpiResid{p.out, p.out, p.out, p.out, (const float*)(p.ws + OFF_MOD), 5, 1.0f, 0}); }
    GSYNC();
    { TIDS; const Params p = load_params();
      if (G == 256) norm_mod_batched(p.out, p.norm_g + 2 * D, (const float*)(p.ws + OFF_MOD), 6, (bf16_t*)(p.ws + OFF_H), L, bid, 256, wid, lane);
      else norm_mod_phase(p.out, p.out, 0, MX, p.norm_g + 2 * D, (const float*)(p.ws + OFF_MOD), 6, (bf16_t*)(p.ws + OFF_H), gw, NGW, lane); }
    GSYNC();
    { const Params p = load_params();
      run_gemm(L, (const bf16_t*)(p.ws + OFF_H), (const bf16_t*)(p.ws + OFF_WT_FFN_IN), MX, NUP, D, EpiSwiglu{(bf16_t*)(p.ws + OFF_G)}); }
    GSYNC();
    { const Params p = load_params();
      run_gemm(L, (const bf16_t*)(p.ws + OFF_G), (const bf16_t*)(p.ws + OFF_WT_FFN_OUT), MX, D, FF, EpiResid{p.out, p.out, p.out, p.out, (const float*)(p.ws + OFF_MOD), 8, 0.5f, 0}); }
    GSYNC();
    { TIDS; const Params p = load_params(); final_norm_phase(p.out, p.final_g, gw, NGW, lane); }
}

extern "C" void kernel_launch(void* const* d_in, const int* in_sizes, int n_in, void* d_out, int out_size, void* d_ws, size_t ws_size, hipStream_t stream) {
    static int grid_blocks = 0;
    if (grid_blocks == 0) {
        if (n_in != 21 || ws_size < WS_END) { fprintf(stderr, "kernel_launch: unexpected n_in %d or ws_size %zu < %zu\n", n_in, ws_size, (size_t)WS_END); grid_blocks = -1; return; }
        int dev = 0, cus = 0, per_cu = 0;
        hipGetDevice(&dev);
        hipDeviceGetAttribute(&cus, hipDeviceAttributeMultiprocessorCount, dev);
        hipFuncSetAttribute((const void*)fwd_megakernel, hipFuncAttributeMaxDynamicSharedMemorySize, LDS_BYTES);
        hipOccupancyMaxActiveBlocksPerMultiprocessor(&per_cu, (const void*)fwd_megakernel, NT, LDS_BYTES);
        if (per_cu < 1) per_cu = 1;
        grid_blocks = cus * per_cu;
        (void)hipGetLastError();
    }
    if (grid_blocks < 0) return;
    Params p{};
    const float** pp = (const float**)&p;
    for (int i = 0; i < 21; ++i) pp[i] = (const float*)d_in[i];
    p.out = (float*)d_out; p.ws = (unsigned char*)d_ws;
    hipMemsetAsync((unsigned char*)d_ws + OFF_BAR, 0, 16384, stream);
    void* args[] = {&p};
    hipError_t e = hipLaunchCooperativeKernel((const void*)fwd_megakernel, dim3(grid_blocks), dim3(NT), args, LDS_BYTES, stream);
    if (e != hipSuccess) fprintf(stderr, "cooperative launch failed: %s (grid %d)\n", hipGetErrorString(e), grid_blocks);
}
```

```cpp
#include <hip/hip_runtime.h>
#include <hip/hip_cooperative_groups.h>
#include <cstdio>
namespace cg = cooperative_groups;
namespace pg8 {
#define PG8_LAS __attribute__((address_space(3)))
typedef unsigned short bf16_t;
typedef short bf16x8 __attribute__((ext_vector_type(8)));
typedef float f32x4 __attribute__((ext_vector_type(4)));
typedef unsigned u32x4 __attribute__((ext_vector_type(4)));
constexpr int BM = 256, BK = 64, HALF = 128, HTB = HALF * BK * 2  , STAGE_BYTES = 8 * HTB, NXCD = 8, WGM = 8;

__host__ __device__ __forceinline__ int lds_byte(int r, int c) { const int st = (r >> 4) * 2 + (c >> 5), rr = r & 15, cc = c & 31, ob = rr * 64 + cc * 2; return st * 1024 + (ob ^ (((ob >> 9) & 1) << 5)); }
__host__ __device__ __forceinline__ void stage_rc(int b, int& R, int& C) { const int st = b / 1024, sb = b % 1024, swz = sb ^ (((sb >> 9) & 1) << 5); R = (st >> 1) * 16 + swz / 64; C = (st & 1) * 32 + (swz % 64) / 2; }
__host__ __device__ __forceinline__ int perm32(int rho) { const int n = rho >> 4, i = rho & 15; return 8 * (i >> 2) + 4 * n + (i & 3); }

struct Unit { int pm, pn; };
struct Gemm { const bf16_t* A; const bf16_t* Bt; int M, N, K; int ld; };

struct StaticOrder {
    int nM, nN, nwg, G, c;
    __host__ __device__ void init(int M, int N, int G_, int c_) { nM = M / BM; nN = N / BM; nwg = nM * nN; G = G_; c = c_; }
    __host__ __device__ bool next(int i, Unit& u) const {
        const long L = (long)i * G + c; if (L >= nwg) return false;
        int wgid = (int)L; { const int q = nwg / NXCD, r = nwg % NXCD, xcd = wgid % NXCD, off = wgid / NXCD; wgid = (xcd < r ? xcd * (q + 1) : r * (q + 1) + (xcd - r) * q) + off; }
        const int nig = WGM * nN, gid = wgid / nig, fm = gid * WGM, gsz = (nM - fm) < WGM ? (nM - fm) : WGM;
        u.pm = fm + ((wgid % nig) % gsz); u.pn = (wgid % nig) / gsz; return true;
    }
    __device__ __forceinline__ void a_ready(const Unit&) const {}
    __device__ __forceinline__ void done(const Unit&) const {}
};
typedef float f32x2_cv __attribute__((ext_vector_type(2)));
typedef __bf16 bf16x2_cv __attribute__((ext_vector_type(2)));
__device__ __forceinline__ unsigned cvt_pk_bf16(float lo, float hi) { const f32x2_cv v = {lo, hi}; const bf16x2_cv r = __builtin_convertvector(v, bf16x2_cv); return __builtin_bit_cast(unsigned, r); }
template <class Epi, class Sched, bool STAMP = false>
__device__ __forceinline__ void gemm_phase(PG8_LAS unsigned char* lds, const Gemm g, const Sched& S, const Epi& E, unsigned long long* stamps) {
    const int tid = threadIdx.x, wid = __builtin_amdgcn_readfirstlane(tid >> 6), lane = tid & 63, wr = wid >> 2, wc = wid & 3, fr = lane & 15, fq = lane >> 4;
    const int K = g.K, nt = K / BK, LD = g.ld ? g.ld : g.K;
    int ts_lo = 0, ts_hi = 0, nts = 0; const unsigned long long rt_entry = STAMP ? (unsigned long long)wall_clock64() : 0ull;
#define PG8_STAMP() do { if (STAMP && wid == 0 && nts < 64) { const unsigned long long _c = (unsigned long long)clock64(); \
        ts_lo = (lane == nts) ? (int)(unsigned)_c : ts_lo; ts_hi = (lane == nts) ? (int)(unsigned)(_c >> 32) : ts_hi; ++nts; } } while (0)
    PG8_STAMP();
    unsigned voffA[2], voffB[2];
#pragma unroll
    for (int i = 0; i < 2; ++i) { int R, C; stage_rc(tid * 16 + i * 8192, R, C); const int Rb = Epi::PERM ? ((R & ~31) + perm32(R & 31)) : R;
        voffA[i] = (unsigned)(R * LD + C) * 2u; voffB[i] = (unsigned)(Rb * LD + C) * 2u; }
    const size_t kstep = (size_t)(BK * 2);
    const size_t hstep = (size_t)HALF * LD * 2;
    const size_t tstep = 2 * hstep;
    const unsigned ldsw = (unsigned)wid * 1024u;
    const int aoff = lds_byte(wr * 64 + fr, fq * 8), boff = lds_byte(wc * 32 + fr, fq * 8);
#define PG8_SA(b, h) (((b) * 2 + (h)) * HTB)
#define PG8_SB(b, h) ((4 + (b) * 2 + (h)) * HTB)
#define PG8_STAGE(bufoff, gbase, voff) do { _Pragma("unroll") for (int _i = 0; _i < 2; ++_i) \
        __builtin_amdgcn_global_load_lds((const unsigned*)((const char*)(gbase) + (voff)[_i]), (PG8_LAS unsigned*)(lds + (bufoff) + ldsw + _i * 8192), 16, 0, 0); } while (0)
#define PG8_LDA(dst, b, h) do { _Pragma("unroll") for (int m = 0; m < 4; ++m) _Pragma("unroll") for (int k = 0; k < 2; ++k) dst[m][k] = *(const PG8_LAS bf16x8*)(lds + PG8_SA(b, h) + aoff + m * 2048 + k * 1024); } while (0)
#define PG8_LDB(dst, b, h) do { _Pragma("unroll") for (int n = 0; n < 2; ++n) _Pragma("unroll") for (int k = 0; k < 2; ++k) dst[n][k] = *(const PG8_LAS bf16x8*)(lds + PG8_SB(b, h) + boff + n * 2048 + k * 1024); } while (0)
#define PG8_MMA(ai, bj, At, Bt) do { __builtin_amdgcn_s_setprio(1); _Pragma("unroll") for (int m = 0; m < 4; ++m) _Pragma("unroll") for (int n = 0; n < 2; ++n) _Pragma("unroll") for (int k = 0; k < 2; ++k) \
        acc[ai][bj][m][n] = __builtin_amdgcn_mfma_f32_16x16x32_bf16(Bt[n][k], At[m][k], acc[ai][bj][m][n], 0, 0, 0); __builtin_amdgcn_s_setprio(0); } while (0)
#define PG8_WAIT_V(n) asm volatile("s_waitcnt vmcnt(" #n ")" ::: "memory")
#define PG8_WAIT_L(n) asm volatile("s_waitcnt lgkmcnt(" #n ")" ::: "memory")
#define PG8_BAR __builtin_amdgcn_s_barrier()
#define PG8_SCHED __builtin_amdgcn_sched_barrier(0)
    Unit cur, nxt; int ui = 0;
    if (!S.next(0, cur)) return;
    f32x4 acc[2][2][4][2];
#pragma unroll
    for (int a = 0; a < 2; ++a)
#pragma unroll
        for (int b = 0; b < 2; ++b)
#pragma unroll
            for (int m = 0; m < 4; ++m)
#pragma unroll
                for (int n = 0; n < 2; ++n) acc[a][b][m][n] = (f32x4){0.f, 0.f, 0.f, 0.f};
    bf16x8 At[4][2], B0[2][2], B1[2][2];
    const char* cA = (const char*)g.A + (size_t)cur.pm * tstep; const char* cB = (const char*)g.Bt + (size_t)cur.pn * tstep;
    S.a_ready(cur);
    PG8_STAGE(PG8_SB(0, 0), cB, voffB); PG8_STAGE(PG8_SA(0, 0), cA, voffA); PG8_STAGE(PG8_SB(0, 1), cB + hstep, voffB); PG8_STAGE(PG8_SA(0, 1), cA + hstep, voffA);
    if (wr == 1) PG8_BAR;
    PG8_WAIT_V(4); PG8_BAR;
    PG8_STAGE(PG8_SB(1, 0), cB + kstep, voffB); PG8_STAGE(PG8_SA(1, 0), cA + kstep, voffA); PG8_STAGE(PG8_SB(1, 1), cB + hstep + kstep, voffB);
    PG8_WAIT_V(6); PG8_BAR;
    PG8_STAMP();
    for (;;) {
        const bool has_next = S.next(ui + 1, nxt);
        const char* nA = has_next ? (const char*)g.A + (size_t)nxt.pm * tstep : cA; const char* nB = has_next ? (const char*)g.Bt + (size_t)nxt.pn * tstep : cB;
        for (int t = 0; t < nt; t += 2) {
            const bool last = (t == nt - 2);
            const char* a1 = cA + (size_t)(t + 1) * kstep;
            const char* a2 = last ? nA : cA + (size_t)(t + 2) * kstep; const char* b2 = last ? nB : cB + (size_t)(t + 2) * kstep;
            const char* a3 = a2 + kstep; const char* b3 = b2 + kstep;
            if (last && has_next) S.a_ready(nxt);
            PG8_LDB(B0, 0, 0); PG8_SCHED; PG8_LDA(At, 0, 0); PG8_STAGE(PG8_SA(1, 1), a1 + hstep, voffA);
            PG8_WAIT_L(8); PG8_BAR; PG8_WAIT_L(0); PG8_MMA(0, 0, At, B0); PG8_BAR; PG8_SCHED;
            PG8_LDB(B1, 0, 1); PG8_STAGE(PG8_SB(0, 0), b2, voffB);
            PG8_BAR; PG8_WAIT_L(0); PG8_MMA(0, 1, At, B1); PG8_BAR;
            PG8_LDA(At, 0, 1); PG8_STAGE(PG8_SA(0, 0), a2, voffA);
            PG8_BAR; PG8_WAIT_L(0); PG8_MMA(1, 0, At, B0); PG8_BAR; PG8_SCHED;
            PG8_STAGE(PG8_SB(0, 1), b2 + hstep, voffB);
            PG8_WAIT_V(6); PG8_BAR; PG8_MMA(1, 1, At, B1); PG8_BAR;
            PG8_LDB(B0, 1, 0); PG8_SCHED; PG8_LDA(At, 1, 0); PG8_STAGE(PG8_SA(0, 1), a2 + hstep, voffA);
            PG8_WAIT_L(8); PG8_BAR; PG8_WAIT_L(0); PG8_MMA(0, 0, At, B0); PG8_BAR; PG8_SCHED;
            PG8_LDB(B1, 1, 1); PG8_STAGE(PG8_SB(1, 0), b3, voffB);
            PG8_BAR; PG8_WAIT_L(0); PG8_MMA(0, 1, At, B1); PG8_BAR;
            PG8_LDA(At, 1, 1); PG8_STAGE(PG8_SA(1, 0), a3, voffA);
            PG8_BAR; PG8_WAIT_L(0); PG8_MMA(1, 0, At, B0); PG8_BAR; PG8_SCHED;
            PG8_STAGE(PG8_SB(1, 1), b3 + hstep, voffB);
            PG8_WAIT_V(6); PG8_BAR; PG8_MMA(1, 1, At, B1); PG8_BAR;
        }
        PG8_STAMP();
        if constexpr (!Epi::AFTER_DRAIN) { E(acc, cur, wr, wc, fr, fq); S.done(cur); }
        PG8_STAMP();
        if (!has_next) break;
#pragma unroll
        for (int a = 0; a < 2; ++a)
#pragma unroll
            for (int b = 0; b < 2; ++b)
#pragma unroll
                for (int m = 0; m < 4; ++m)
#pragma unroll
                    for (int n = 0; n < 2; ++n) acc[a][b][m][n] = (f32x4){0.f, 0.f, 0.f, 0.f};
        cur = nxt; cA = nA; cB = nB; ++ui;
    }
    PG8_WAIT_V(0);
    if (wr == 0) PG8_BAR;
    PG8_BAR;
    if constexpr (Epi::AFTER_DRAIN) { E.fused(acc, cur, wr, wc, fr, fq, lds, wid, lane); S.done(cur); }
    PG8_STAMP();
    if (STAMP && wid == 0) { stamps[lane] = lane < nts ? (((unsigned long long)(unsigned)ts_hi << 32) | (unsigned)ts_lo) : 0ull;
        if (lane == 62) stamps[62] = rt_entry; if (lane == 63) stamps[63] = (unsigned long long)wall_clock64(); }
#undef PG8_STAMP
#undef PG8_SA
#undef PG8_SB
#undef PG8_STAGE
#undef PG8_LDA
#undef PG8_LDB
#undef PG8_MMA
#undef PG8_WAIT_V
#undef PG8_WAIT_L
#undef PG8_BAR
#undef PG8_SCHED
}
}

using pg8::bf16_t; using pg8::bf16x8; using pg8::f32x4; using pg8::u32x4; using pg8::Unit; using pg8::cvt_pk_bf16;
typedef unsigned u32x2 __attribute__((ext_vector_type(2)));
#define DI __device__ __forceinline__
#define LAS __attribute__((address_space(3)))
#define MFMA16(a, b, c) __builtin_amdgcn_mfma_f32_16x16x32_bf16((a), (b), (c), 0, 0, 0)

constexpr int NT = 512;
constexpr int D = 2048, FF = 5504, NUP = 11008, NIN = 6400;
constexpr int MX = 16384, MC = 2048, MALL = 18432;
constexpr int NMOD = 18432;
constexpr int LDS_BYTES = 159744;

constexpr size_t OFF_WT_FFN_IN = 0;
constexpr size_t OFF_WT_FFN_OUT = OFF_WT_FFN_IN + (size_t)NUP * D * 2;
constexpr size_t OFF_WT_OUT = OFF_WT_FFN_OUT + (size_t)D * FF * 2;
constexpr size_t OFF_MOD = OFF_WT_OUT + (size_t)D * D * 2;
constexpr size_t OFF_AB = OFF_MOD + (size_t)9 * NMOD * 4;
constexpr size_t OFF_SST = OFF_AB + (size_t)MALL * 32 * 4;
constexpr size_t OFF_Z0 = OFF_SST + (size_t)256 * 8192 * 4;
constexpr size_t OFF_G = OFF_Z0;
constexpr size_t OFF_ZQKV = OFF_Z0;
constexpr size_t OFF_ZG = OFF_ZQKV + (size_t)MALL * 3072 * 2;
constexpr size_t OFF_ZU = OFF_ZG + (size_t)MX * 1024 * 2;
constexpr size_t OFF_ZV = OFF_ZU + (size_t)MX * 1024 * 2;
constexpr size_t OFF_H = OFF_ZV + (size_t)MX * 1024 * 2;
constexpr size_t OFF_ODIR = OFF_H;
constexpr size_t OFF_WT_IN = OFF_H + (size_t)MALL * D * 2;
constexpr size_t OFF_CTX1 = OFF_WT_IN + (size_t)NIN * D * 2;
constexpr size_t OFF_PREP = OFF_WT_IN;
constexpr int PREP_STRIDE = 73984;
constexpr int PI_W = 0, PI_U = 16384, PI_QD = 32768, PI_KDT = 49152, PI_QK = 65536, PI_GL = 73728;
constexpr int NSTEP = 36, NROUND = 2, RSTEPS = NSTEP / NROUND;
constexpr int PREP_ITEMS = 8 * 8 * 2 * RSTEPS;
constexpr size_t OFF_O = OFF_PREP + (size_t)PREP_ITEMS * PREP_STRIDE;
constexpr size_t OFF_BAR = OFF_O + (size_t)MX * D * 2;
constexpr size_t WS_END = OFF_BAR + 16384;
static_assert(OFF_G + (size_t)MALL * FF * 2 <= OFF_H, "G vs H");
static_assert((size_t)2 * MX * 1024 * 2 <= (size_t)MALL * D * 2, "ODIR fits H");
static_assert(OFF_CTX1 + (size_t)2 * MC * D * 4 <= OFF_O, "ctx1 / split-K partials");

struct Params {
    const float *x, *c, *ctx, *c_ctx, *w_mod, *b_mod, *norm_g, *ffn1_w_in, *ffn1_w_out, *w_in, *conv_w, *a_log, *dt_bias, *head_norm_g,
        *spatial_w, *spatial_b, *mlp_norm_g, *w_out, *ffn2_w_in, *ffn2_w_out, *final_g;
    float* out; unsigned char* ws;
};

typedef const __attribute__((address_space(4))) unsigned long long* kargp_t;
typedef __attribute__((address_space(1))) unsigned char* gptr_t;
DI Params load_params() {
    kargp_t k = (kargp_t)__builtin_amdgcn_kernarg_segment_ptr();
    asm volatile("" : "+s"(k));
    Params q;
#define LP(i) ((gptr_t)k[i])
    q.x = (const float*)LP(0); q.c = (const float*)LP(1); q.ctx = (const float*)LP(2); q.c_ctx = (const float*)LP(3); q.w_mod = (const float*)LP(4);
    q.b_mod = (const float*)LP(5); q.norm_g = (const float*)LP(6); q.ffn1_w_in = (const float*)LP(7); q.ffn1_w_out = (const float*)LP(8); q.w_in = (const float*)LP(9);
    q.conv_w = (const float*)LP(10); q.a_log = (const float*)LP(11); q.dt_bias = (const float*)LP(12); q.head_norm_g = (const float*)LP(13); q.spatial_w = (const float*)LP(14);
    q.spatial_b = (const float*)LP(15); q.mlp_norm_g = (const float*)LP(16); q.w_out = (const float*)LP(17); q.ffn2_w_in = (const float*)LP(18); q.ffn2_w_out = (const float*)LP(19);
    q.final_g = (const float*)LP(20); q.out = (float*)LP(21); q.ws = (unsigned char*)LP(22);
#undef LP
    return q;
}
DI float bflo(unsigned u) { return __uint_as_float(u << 16); }
DI float bfhi(unsigned u) { return __uint_as_float(u & 0xffff0000u); }
DI float bf2f(bf16_t b) { return __uint_as_float(((unsigned)b) << 16); }
DI unsigned f2bf(float f) { unsigned u = __float_as_uint(f); return (u + 0x7fffu + ((u >> 16) & 1u)) >> 16; }
DI float silu_f(float x) { return x * __builtin_amdgcn_rcpf(1.0f + __expf(-x)); }
DI float gelu_f(float x) { const float u = 1.5957691216057308f * (x + 0.044715f * x * x * x); return x * __builtin_amdgcn_rcpf(1.0f + __expf(-u)); }
DI float wave_sum(float v) {
#pragma unroll
    for (int o = 1; o < 64; o <<= 1) v += __shfl_xor(v, o);
    return v;
}

struct EpiSwiglu {
    static constexpr bool PERM = true, AFTER_DRAIN = false;
    bf16_t* G;
    DI void operator()(const f32x4 (&acc)[2][2][4][2], const Unit& u, int wr, int wc, int fr, int fq) const {
        const int row0 = u.pm * 256 + wr * 64 + fr, col0 = u.pn * 128 + wc * 32 + 8 * fq;
#pragma unroll
        for (int ai = 0; ai < 2; ++ai)
#pragma unroll
            for (int m = 0; m < 4; ++m) {
                const f32x4 a0 = acc[ai][0][m][0], a1 = acc[ai][0][m][1], b0 = acc[ai][1][m][0], b1 = acc[ai][1][m][1];
                u32x4 w;
                w.x = cvt_pk_bf16(silu_f(a0[0]) * b0[0], silu_f(a0[1]) * b0[1]); w.y = cvt_pk_bf16(silu_f(a0[2]) * b0[2], silu_f(a0[3]) * b0[3]);
                w.z = cvt_pk_bf16(silu_f(a1[0]) * b1[0], silu_f(a1[1]) * b1[1]); w.w = cvt_pk_bf16(silu_f(a1[2]) * b1[2], silu_f(a1[3]) * b1[3]);
                *(u32x4*)(G + (size_t)(row0 + ai * 128 + m * 16) * FF + col0) = w;
            }
    }
};
struct EpiResid {
    static constexpr bool PERM = false, AFTER_DRAIN = false;
    const float* srcx; const float* srcc; float* dstx; float* dstc; const float* mod; int gate_idx; float coef; int ctx_only;
    DI void operator()(const f32x4 (&acc)[2][2][4][2], const Unit& u, int wr, int wc, int fr, int fq) const {
        const bool isc = ctx_only || u.pm >= 64; const int mb = isc ? 8 : (u.pm >> 3);
        const int row0 = ((isc && !ctx_only) ? (u.pm - 64) : u.pm) * 256 + wr * 64 + fr, col0 = u.pn * 256 + wc * 32 + 4 * fq;
        const float* src = isc ? srcc : srcx; float* dst = isc ? dstc : dstx;
        const float* gate = mod + (size_t)mb * NMOD + gate_idx * D + col0;
        f32x4 gv[2][2];
#pragma unroll
        for (int bj = 0; bj < 2; ++bj)
#pragma unroll
            for (int n = 0; n < 2; ++n) gv[bj][n] = *(const f32x4*)(gate + bj * 128 + n * 16) * coef;
#pragma unroll
        for (int ai = 0; ai < 2; ++ai)
#pragma unroll
            for (int m = 0; m < 4; ++m) {
                const size_t off = (size_t)(row0 + ai * 128 + m * 16) * D + col0;
#pragma unroll
                for (int bj = 0; bj < 2; ++bj)
#pragma unroll
                    for (int n = 0; n < 2; ++n) {
                        const f32x4 s = *(const f32x4*)(src + off + bj * 128 + n * 16);
                        *(f32x4*)(dst + off + bj * 128 + n * 16) = s + gv[bj][n] * acc[ai][bj][m][n];
                    }
                if (m & 1) asm volatile("" ::: "memory");
            }
    }
};
struct EpiPartial {
    static constexpr bool PERM = false, AFTER_DRAIN = false;
    float* P;
    DI void operator()(const f32x4 (&acc)[2][2][4][2], const Unit& u, int wr, int wc, int fr, int fq) const {
        const int row0 = u.pm * 256 + wr * 64 + fr, col0 = u.pn * 256 + wc * 32 + 4 * fq;
#pragma unroll
        for (int ai = 0; ai < 2; ++ai)
#pragma unroll
            for (int m = 0; m < 4; ++m) {
                float* rp = P + (size_t)(row0 + ai * 128 + m * 16) * D + col0;
#pragma unroll
                for (int bj = 0; bj < 2; ++bj)
#pragma unroll
                    for (int n = 0; n < 2; ++n) *(f32x4*)(rp + bj * 128 + n * 16) = acc[ai][bj][m][n];
            }
    }
};
struct EpiInproj {
    static constexpr bool PERM = true, AFTER_DRAIN = false;
    unsigned char* ws;
    DI void operator()(const f32x4 (&acc)[2][2][4][2], const Unit& u, int wr, int wc, int fr, int fq) const {
        const int row0 = u.pm * 256 + wr * 64 + fr;
        if (u.pn == 24) {
            if (wc == 0) {
                float* AB = (float*)(ws + OFF_AB);
#pragma unroll
                for (int ai = 0; ai < 2; ++ai)
#pragma unroll
                    for (int m = 0; m < 4; ++m) {
                        float* rp = AB + (size_t)(row0 + ai * 128 + m * 16) * 32 + 8 * fq;
                        *(f32x4*)rp = acc[ai][0][m][0]; *(f32x4*)(rp + 4) = acc[ai][0][m][1];
                    }
            }
            return;
        }
        if (u.pn >= 12 && u.pm >= 64) return;
        int act, ld, colt; bf16_t* base;
        if (u.pn < 12) { act = 0; ld = 3072; colt = u.pn * 256; base = (bf16_t*)(ws + OFF_ZQKV); }
        else if (u.pn < 16) { act = 1; ld = 1024; colt = (u.pn - 12) * 256; base = (bf16_t*)(ws + OFF_ZG); }
        else if (u.pn < 20) { act = 2; ld = 1024; colt = (u.pn - 16) * 256; base = (bf16_t*)(ws + OFF_ZU); }
        else { act = 2; ld = 1024; colt = (u.pn - 20) * 256; base = (bf16_t*)(ws + OFF_ZV); }
        const int col0 = colt + wc * 32 + 8 * fq;
#pragma unroll
        for (int ai = 0; ai < 2; ++ai)
#pragma unroll
            for (int m = 0; m < 4; ++m) {
                bf16_t* rowp = base + (size_t)(row0 + ai * 128 + m * 16) * ld + col0;
#pragma unroll
                for (int bj = 0; bj < 2; ++bj) {
                    f32x4 v0 = acc[ai][bj][m][0], v1 = acc[ai][bj][m][1];
                    if (act == 1) {
#pragma unroll
                        for (int j = 0; j < 4; ++j) { v0[j] = silu_f(v0[j]); v1[j] = silu_f(v1[j]); }
                    } else if (act == 2) {
#pragma unroll
                        for (int j = 0; j < 4; ++j) { v0[j] = gelu_f(v0[j]); v1[j] = gelu_f(v1[j]); }
                    }
                    u32x4 w; w.x = cvt_pk_bf16(v0[0], v0[1]); w.y = cvt_pk_bf16(v0[2], v0[3]); w.z = cvt_pk_bf16(v1[0], v1[1]); w.w = cvt_pk_bf16(v1[2], v1[3]);
                    *(u32x4*)(rowp + bj * 128) = w;
                }
            }
    }
};

DI int src_col(int mode, int n) {
    if (mode == 1) { const int pn = n >> 8, j = n & 255; return j < 128 ? pn * 128 + j : FF + pn * 128 + (j - 128); }
    if (mode == 2) { if (n < 4096) return n; if (n < 6144) return n + 32; if (n < 6176) return n - 6144 + 4096; return -1; }
    return n;
}
DI void transpose_item(const float* W, int K, int N, int Ndst, int mode, bf16_t* WT, LAS float* scr, int item, int lane) {
    const int nblk = Ndst / 64, kb = item / nblk, nb = item % nblk, k0 = 64 * kb, n0 = 64 * nb;
    const int rsub = lane >> 4, cg = lane & 15;
    const int s0 = src_col(mode, n0 + cg * 4);
    f32x4 v[16];
    if (s0 >= 0) {
        const float* wp = W + (size_t)(k0 + rsub) * N + s0;
#pragma unroll
        for (int i = 0; i < 16; ++i) v[i] = __builtin_nontemporal_load((const f32x4*)(wp + (size_t)(i * 4) * N));
    } else {
#pragma unroll
        for (int i = 0; i < 16; ++i) v[i] = (f32x4){0.f, 0.f, 0.f, 0.f};
    }
#pragma unroll
    for (int i = 0; i < 16; ++i) { LAS float* d = scr + (i * 4 + rsub) * 65 + cg * 4; d[0] = v[i].x; d[1] = v[i].y; d[2] = v[i].z; d[3] = v[i].w; }
    asm volatile("s_waitcnt lgkmcnt(0)" ::: "memory");
    const int c = lane & 7, nl = lane >> 3;
#pragma unroll
    for (int j = 0; j < 8; ++j) {
        const int n = nl + 8 * j; const LAS float* sp = scr + (8 * c) * 65 + n;
        u32x4 o; o.x = cvt_pk_bf16(sp[0 * 65], sp[1 * 65]); o.y = cvt_pk_bf16(sp[2 * 65], sp[3 * 65]); o.z = cvt_pk_bf16(sp[4 * 65], sp[5 * 65]); o.w = cvt_pk_bf16(sp[6 * 65], sp[7 * 65]);
        *(u32x4*)(WT + (size_t)(n0 + n) * K + k0 + 8 * c) = o;
    }
    asm volatile("s_waitcnt lgkmcnt(0)" ::: "memory");
}
DI void convert_weights(const float* W, int K, int N, int Ndst, int mode, bf16_t* WT, LAS unsigned char* L, int gw, int NGW, int wid, int lane, int sel = 0, int nsel = 1) {
    LAS float* scr = (LAS float*)(L + wid * 16640);
    const int nitems = (K / 64) * (Ndst / 64);
    for (int it = gw * nsel + sel; it < nitems; it += NGW * nsel) transpose_item(W, K, N, Ndst, mode, WT, scr, it, lane);
}

DI void mod_gemv(const Params& p, LAS unsigned char* L, int bid, int G) {
    const int tid = threadIdx.x, lane = tid & 63, wid = tid >> 6;
    LAS float* sc = (LAS float*)L;
    LAS float* red = (LAS float*)(L + 9 * 2048 * 4);
    for (int i = tid; i < 9 * 2048; i += NT) { const int r = i >> 11, k = i & 2047; const float v = r < 8 ? p.c[r * 2048 + k] : p.c_ctx[k]; sc[i] = silu_f(v); }
    __syncthreads();
    float* MOD = (float*)(p.ws + OFF_MOD);
    const int cgi = lane & 15, ksub = lane >> 4, ks = wid * 4 + ksub;
    for (int item = bid; item < NMOD / 64; item += G) {
        const int n0 = item * 64;
        f32x4 acc[9];
#pragma unroll
        for (int r = 0; r < 9; ++r) acc[r] = (f32x4){0.f, 0.f, 0.f, 0.f};
        const float* wp = p.w_mod + (size_t)(ks * 64) * NMOD + n0 + cgi * 4;
#pragma unroll 8
        for (int kk = 0; kk < 64; ++kk) {
            const f32x4 wv = __builtin_nontemporal_load((const f32x4*)(wp + (size_t)kk * NMOD));
#pragma unroll
            for (int r = 0; r < 9; ++r) acc[r] += wv * sc[r * 2048 + ks * 64 + kk];
        }
#pragma unroll
        for (int r = 0; r < 9; ++r)
#pragma unroll
            for (int j = 0; j < 4; ++j) { float v = acc[r][j]; v += __shfl_xor(v, 16); v += __shfl_xor(v, 32); acc[r][j] = v; }
        if (ksub == 0) {
#pragma unroll
            for (int r = 0; r < 9; ++r) *(LAS f32x4*)(red + (wid * 9 + r) * 64 + cgi * 4) = acc[r];
        }
        __syncthreads();
        for (int i = tid; i < 9 * 64; i += NT) {
            const int r = i >> 6, col = i & 63; float s = p.b_mod[n0 + col];
#pragma unroll
            for (int w = 0; w < 8; ++w) s += red[(w * 9 + r) * 64 + col];
            MOD[(size_t)r * NMOD + n0 + col] = s;
        }
        __syncthreads();
    }
}

DI void norm_mod_phase(const float* srcx, const float* srcc, int row0, int nrows, const float* g, const float* mod, int shift_idx, bf16_t* H, int gw, int NGW, int lane) {
    gw += row0;
    f32x4 nx[8];
    if (gw < nrows) { const float* src = gw < MX ? srcx + (size_t)gw * D : srcc + (size_t)(gw - MX) * D; const f32x4* xr = (const f32x4*)src + lane;
#pragma unroll
        for (int j = 0; j < 8; ++j) nx[j] = xr[64 * j]; }
    for (int r = gw; r < nrows; r += NGW) {
        const int mb = r < MX ? (r >> 11) : 8;
        f32x4 v[8]; float ss = 0.f;
#pragma unroll
        for (int j = 0; j < 8; ++j) { v[j] = nx[j]; ss += (v[j].x * v[j].x + v[j].y * v[j].y) + (v[j].z * v[j].z + v[j].w * v[j].w); }
        const int rn = r + NGW;
        if (rn < nrows) { const float* src = rn < MX ? srcx + (size_t)rn * D : srcc + (size_t)(rn - MX) * D; const f32x4* xr = (const f32x4*)src + lane;
#pragma unroll
            for (int j = 0; j < 8; ++j) nx[j] = xr[64 * j]; }
        const float rstd = rsqrtf(wave_sum(ss) * (1.0f / D) + 1e-6f);
        const float* sh = mod + (size_t)mb * NMOD + shift_idx * D; const float* scl = sh + D;
        u32x2* o8 = (u32x2*)(H + (size_t)r * D) + lane;
#pragma unroll
        for (int j = 0; j < 8; ++j) {
            const int c = (lane + 64 * j) * 4;
            const f32x4 gg = *(const f32x4*)(g + c), s1 = *(const f32x4*)(scl + c), s0 = *(const f32x4*)(sh + c);
            const f32x4 y = (v[j] * rstd) * gg * (s1 + 1.0f) + s0;
            u32x2 w; w.x = cvt_pk_bf16(y.x, y.y); w.y = cvt_pk_bf16(y.z, y.w); o8[64 * j] = w;
        }
    }
}
DI void norm_mod_batched(const float* src, const float* g, const float* mod, int shift_idx, bf16_t* H, LAS unsigned char* L, int q, int P, int wid, int lane) {
    const int per = P >> 3, b = q / per, j = q - b * per;
    LAS float* gam = (LAS float*)L; LAS float* shf = gam + 2048;
    { const float* sh = mod + (size_t)b * NMOD + shift_idx * D; const float* scl = sh + D;
      for (int i = threadIdx.x; i < 2048; i += NT) { gam[i] = g[i] * (1.0f + scl[i]); shf[i] = sh[i]; } }
    __syncthreads();
    const int k0 = j + wid * per, kstep = 8 * per;
    f32x4 nx[8];
    if (k0 < 2048) { const f32x4* xr = (const f32x4*)(src + ((size_t)b * 2048 + k0) * D) + lane;
#pragma unroll
        for (int jj = 0; jj < 8; ++jj) nx[jj] = xr[64 * jj]; }
    for (int k = k0; k < 2048; k += kstep) {
        const size_t r = (size_t)b * 2048 + k;
        f32x4 v[8]; float ss = 0.f;
#pragma unroll
        for (int jj = 0; jj < 8; ++jj) { v[jj] = nx[jj]; ss += (v[jj].x * v[jj].x + v[jj].y * v[jj].y) + (v[jj].z * v[jj].z + v[jj].w * v[jj].w); }
        const int kn = k + kstep;
        if (kn < 2048) { const f32x4* xr = (const f32x4*)(src + ((size_t)b * 2048 + kn) * D) + lane;
#pragma unroll
            for (int jj = 0; jj < 8; ++jj) nx[jj] = xr[64 * jj]; }
        const float rstd = rsqrtf(wave_sum(ss) * (1.0f / D) + 1e-6f);
        u32x2* o8 = (u32x2*)(H + r * D) + lane;
#pragma unroll
        for (int jj = 0; jj < 8; ++jj) {
            const int c = (lane + 64 * jj) * 4;
            const f32x4 y = (v[jj] * rstd) * *(const LAS f32x4*)(gam + c) + *(const LAS f32x4*)(shf + c);
            u32x2 w; w.x = cvt_pk_bf16(y.x, y.y); w.y = cvt_pk_bf16(y.z, y.w); o8[64 * jj] = w;
        }
    }
    __syncthreads();
}
DI void ctx_norm_from_partials(const float* ctx, const float* Pa, const float* Pb, const float* g, const float* mod, bf16_t* H, int gw, int NGW, int lane) {
    const float* m8 = mod + (size_t)8 * NMOD;
    for (int r = gw; r < MC; r += NGW) {
        const f32x4* xr = (const f32x4*)(ctx + (size_t)r * D) + lane; const f32x4* pa = (const f32x4*)(Pa + (size_t)r * D) + lane; const f32x4* pb = (const f32x4*)(Pb + (size_t)r * D) + lane;
        f32x4 v[8]; float ss = 0.f;
#pragma unroll
        for (int j = 0; j < 8; ++j) {
            const int c = (lane + 64 * j) * 4;
            const f32x4 gt = *(const f32x4*)(m8 + 2 * D + c) * 0.5f;
            v[j] = xr[64 * j] + gt * (pa[64 * j] + pb[64 * j]);
            ss += (v[j].x * v[j].x + v[j].y * v[j].y) + (v[j].z * v[j].z + v[j].w * v[j].w);
        }
        const float rstd = rsqrtf(wave_sum(ss) * (1.0f / D) + 1e-6f);
        u32x2* o8 = (u32x2*)(H + (size_t)(MX + r) * D) + lane;
#pragma unroll
        for (int j = 0; j < 8; ++j) {
            const int c = (lane + 64 * j) * 4;
            const f32x4 gg = *(const f32x4*)(g + c), s1 = *(const f32x4*)(m8 + 4 * D + c), s0 = *(const f32x4*)(m8 + 3 * D + c);
            const f32x4 y = (v[j] * rstd) * gg * (s1 + 1.0f) + s0;
            u32x2 w; w.x = cvt_pk_bf16(y.x, y.y); w.y = cvt_pk_bf16(y.z, y.w); o8[64 * j] = w;
        }
    }
}
DI void final_norm_phase(float* xo, const float* g, int gw, int NGW, int lane) {
    f32x4 nx[8];
    if (gw < MX) { const f32x4* xr = (const f32x4*)(xo + (size_t)gw * D) + lane;
#pragma unroll
        for (int j = 0; j < 8; ++j) nx[j] = xr[64 * j]; }
    for (int r = gw; r < MX; r += NGW) {
        f32x4* xw = (f32x4*)(xo + (size_t)r * D) + lane;
        f32x4 v[8]; float ss = 0.f;
#pragma unroll
        for (int j = 0; j < 8; ++j) { v[j] = nx[j]; ss += (v[j].x * v[j].x + v[j].y * v[j].y) + (v[j].z * v[j].z + v[j].w * v[j].w); }
        const int rn = r + NGW;
        if (rn < MX) { const f32x4* xr = (const f32x4*)(xo + (size_t)rn * D) + lane;
#pragma unroll
            for (int j = 0; j < 8; ++j) nx[j] = xr[64 * j]; }
        const float rstd = rsqrtf(wave_sum(ss) * (1.0f / D) + 1e-6f);
#pragma unroll
        for (int j = 0; j < 8; ++j) { const int c = (lane + 64 * j) * 4; xw[64 * j] = (v[j] * rstd) * *(const f32x4*)(g + c); }
    }
}

constexpr int PL_QN = 0, PL_KN = 17408, PL_KT = 34816, PL_VT = 53248, PL_KK = 71680, PL_QK = 88320, PL_LC1 = 104960, PL_TB = 121344, PL_VEC = 158208;
static_assert(PL_VEC + 1024 <= LDS_BYTES, "prep lds");

DI void dn_prep_item(const Params& p, LAS unsigned char* L, int b, int c, int h) {
    int tid_ = threadIdx.x; asm volatile("" : "+v"(tid_));
    const int tid = tid_, lane = tid & 63, wid = tid >> 6, fr = lane & 15, fq = lane >> 4;
    LAS bf16_t* Qn = (LAS bf16_t*)(L + PL_QN); LAS bf16_t* Kn = (LAS bf16_t*)(L + PL_KN);
    LAS bf16_t* KT = (LAS bf16_t*)(L + PL_KT); LAS bf16_t* VT = (LAS bf16_t*)(L + PL_VT);
    LAS float* KKf = (LAS float*)(L + PL_KK); LAS float* QKf = (LAS float*)(L + PL_QK);
    int base_row, seq_lo, seq_hi;
    if (c < 4) { seq_lo = MX + b * 256; seq_hi = seq_lo + 256; base_row = seq_lo + c * 64; }
    else { seq_lo = b * 2048; seq_hi = seq_lo + 2048; base_row = seq_lo + (c - 4) * 64; }
    const bool is_lat = c >= 4;
    const int dw = __builtin_amdgcn_readfirstlane(wid) & 1;
#define SLOT_OF(dd) ((size_t)(((((b & 3) * 8 + h) * 2 + (dd)) * 36) + ((dd) == 0 ? c : (c < 4 ? 3 - c : 39 - c))))
#define LC_OF(dd) ((LAS float*)(L + ((dd) ? PL_LC1 : PL_KN)))
#define TB_OF(dd) ((LAS bf16_t*)(L + PL_TB + (dd) * 18432))
#define TBG_OF(dd) ((LAS bf16_t*)(L + PL_TB + (dd) * 18432 + 9216))
#define VGC_OF(dd) ((LAS float*)(L + PL_VEC) + (dd) * 128)

    float ab_a = 0.f, ab_b = 0.f;
    if (wid < 2) {
        const int tok = dw ? 63 - lane : lane;
        const float* AB = (const float*)(p.ws + OFF_AB) + (size_t)(base_row + tok) * 32;
        ab_a = AB[dw * 8 + h]; ab_b = AB[16 + dw * 8 + h];
    }
    LAS bf16_t* Zs = (LAS bf16_t*)(L + PL_KK);
    LAS float* Ws = (LAS float*)(L + PL_KK + 53312);
    {
        const bf16_t* Z = (const bf16_t*)(p.ws + OFF_ZQKV);
        u32x4 zr[7]; f32x4 wr4 = (f32x4){0.f, 0.f, 0.f, 0.f};
#pragma unroll
        for (int e = 0; e < 7; ++e) {
            const int idx = tid + NT * e; zr[e] = (u32x4){0u, 0u, 0u, 0u};
            if (idx < 68 * 48) {
                const int row = idx / 48, rem = idx - row * 48, seg = rem >> 4, c16 = rem & 15, rr = base_row - 2 + row;
                if (rr >= seq_lo && rr < seq_hi) zr[e] = *(const u32x4*)(Z + (size_t)rr * 3072 + seg * 1024 + h * 128 + c16 * 8);
            }
        }
        if (tid < 480) { const int j = tid / 96, rem = tid - j * 96, seg = rem >> 5, c4 = rem & 31; wr4 = *(const f32x4*)(p.conv_w + j * 3072 + seg * 1024 + h * 128 + c4 * 4); }
#pragma unroll
        for (int e = 0; e < 7; ++e) {
            const int idx = tid + NT * e;
            if (idx < 68 * 48) { const int row = idx / 48, rem = idx - row * 48, seg = rem >> 4, c16 = rem & 15; *(LAS u32x4*)(Zs + row * 392 + seg * 128 + c16 * 8) = zr[e]; }
        }
        if (tid < 480) { const int j = tid / 96, rem = tid - j * 96, seg = rem >> 5, c4 = rem & 31; *(LAS f32x4*)(Ws + j * 384 + seg * 128 + c4 * 4) = wr4; }
    }
    __syncthreads();
    {
        const int t = tid & 63, sg = tid >> 6;
        LAS float* ssb = (LAS float*)(L + PL_TB + 2 * 18432 - 4096);
        float yq[16], yk[16];
#pragma unroll
        for (int seg = 0; seg < 3; ++seg) {
            float y[16];
#pragma unroll
            for (int hf = 0; hf < 2; ++hf) {
                typedef float f32x2 __attribute__((ext_vector_type(2)));
                f32x2 ap[4];
#pragma unroll
                for (int i = 0; i < 4; ++i) ap[i] = (f32x2){0.f, 0.f};
#pragma unroll
                for (int j = 0; j < 5; ++j) {
                    const u32x4 zz = *(const LAS u32x4*)(Zs + (t + j) * 392 + seg * 128 + sg * 16 + hf * 8);
                    const LAS float* cw = Ws + j * 384 + seg * 128 + sg * 16 + hf * 8;
                    const f32x4 w0 = *(const LAS f32x4*)cw, w1 = *(const LAS f32x4*)(cw + 4);
                    ap[0] += (f32x2){w0.x, w0.y} * (f32x2){bflo(zz.x), bfhi(zz.x)}; ap[1] += (f32x2){w0.z, w0.w} * (f32x2){bflo(zz.y), bfhi(zz.y)};
                    ap[2] += (f32x2){w1.x, w1.y} * (f32x2){bflo(zz.z), bfhi(zz.z)}; ap[3] += (f32x2){w1.z, w1.w} * (f32x2){bflo(zz.w), bfhi(zz.w)};
                }
#pragma unroll
                for (int i = 0; i < 4; ++i) { y[hf * 8 + 2 * i] = silu_f(ap[i].x); y[hf * 8 + 2 * i + 1] = silu_f(ap[i].y); }
            }
            if (seg < 2) {
                float ss = 0.f;
#pragma unroll
                for (int i = 0; i < 16; ++i) ss += y[i] * y[i];
                ssb[(seg * 8 + sg) * 64 + t] = ss;
#pragma unroll
                for (int i = 0; i < 16; ++i) { if (seg == 0) yq[i] = y[i]; else yk[i] = y[i]; }
            } else {
                LAS bf16_t* dstT = VT + (sg * 16) * 72 + t;
#pragma unroll
                for (int i = 0; i < 16; ++i) dstT[i * 72] = (bf16_t)f2bf(y[i]);
            }
        }
        __syncthreads();
        float sq = 0.f, sk = 0.f;
#pragma unroll
        for (int w = 0; w < 8; ++w) { sq += ssb[w * 64 + t]; sk += ssb[(8 + w) * 64 + t]; }
        const float scq = rsqrtf(sq + 1e-6f) * 0.08838834764831845f, sck = rsqrtf(sk + 1e-6f);
#pragma unroll
        for (int i = 0; i < 16; ++i) { yq[i] *= scq; yk[i] *= sck; }
        {
            u32x4 w0, w1;
            w0.x = cvt_pk_bf16(yq[0], yq[1]); w0.y = cvt_pk_bf16(yq[2], yq[3]); w0.z = cvt_pk_bf16(yq[4], yq[5]); w0.w = cvt_pk_bf16(yq[6], yq[7]);
            w1.x = cvt_pk_bf16(yq[8], yq[9]); w1.y = cvt_pk_bf16(yq[10], yq[11]); w1.z = cvt_pk_bf16(yq[12], yq[13]); w1.w = cvt_pk_bf16(yq[14], yq[15]);
            LAS bf16_t* dq = Qn + t * 136 + sg * 16; *(LAS u32x4*)dq = w0; *(LAS u32x4*)(dq + 8) = w1;
            w0.x = cvt_pk_bf16(yk[0], yk[1]); w0.y = cvt_pk_bf16(yk[2], yk[3]); w0.z = cvt_pk_bf16(yk[4], yk[5]); w0.w = cvt_pk_bf16(yk[6], yk[7]);
            w1.x = cvt_pk_bf16(yk[8], yk[9]); w1.y = cvt_pk_bf16(yk[10], yk[11]); w1.z = cvt_pk_bf16(yk[12], yk[13]); w1.w = cvt_pk_bf16(yk[14], yk[15]);
            LAS bf16_t* dk2 = Kn + t * 136 + sg * 16; *(LAS u32x4*)dk2 = w0; *(LAS u32x4*)(dk2 + 8) = w1;
            LAS bf16_t* dstT = KT + (sg * 16) * 72 + t;
#pragma unroll
            for (int i = 0; i < 16; ++i) dstT[i * 72] = (bf16_t)f2bf(yk[i]);
        }
    }
    if (wid < 2) {
        LAS float* vgc = VGC_OF(dw); LAS float* vbeta = vgc + 64;
        const float xx = ab_a + p.dt_bias[dw * 8 + h];
        const float sp = xx > 20.f ? xx : log1pf(expf(xx));
        float gcv = -expf(p.a_log[dw * 8 + h]) * sp;
#pragma unroll
        for (int o = 1; o < 64; o <<= 1) { const float t = __shfl_up(gcv, o); if (lane >= o) gcv += t; }
        vgc[lane] = gcv; vbeta[lane] = 1.0f / (1.0f + expf(-ab_b));
    }
    __syncthreads();
    {
        const LAS bf16_t* Am = (wid >> 2) ? Qn : Kn; LAS float* Mo = (wid >> 2) ? QKf : KKf; const int ti = wid & 3;
        bf16x8 af[4];
#pragma unroll
        for (int k = 0; k < 4; ++k) af[k] = *(const LAS bf16x8*)(Am + (ti * 16 + fr) * 136 + k * 32 + fq * 8);
#pragma unroll
        for (int tj = 0; tj < 4; ++tj) {
            f32x4 acc = (f32x4){0.f, 0.f, 0.f, 0.f};
#pragma unroll
            for (int k = 0; k < 4; ++k) acc = MFMA16(af[k], *(const LAS bf16x8*)(Kn + (tj * 16 + fr) * 136 + k * 32 + fq * 8), acc);
#pragma unroll
            for (int j = 0; j < 4; ++j) Mo[(ti * 16 + fq * 4 + j) * 65 + tj * 16 + fr] = acc[j];
        }
    }
    __syncthreads();
#pragma unroll
    for (int dd = 0; dd < 2; ++dd) {
        const LAS float* vgc = VGC_OF(dd); const LAS float* vbeta = vgc + 64; LAS float* Lc = LC_OF(dd);
#pragma unroll
        for (int e = 0; e < 8; ++e) {
            const int idx = tid + NT * e, j = idx >> 6, i = idx & 63;
            const int ti = dd ? 63 - i : i, tj = dd ? 63 - j : j;
            Lc[idx] = (i > j) ? vbeta[i] * KKf[ti * 65 + tj] * __expf(vgc[i] - vgc[j]) : 0.f;
        }
    }
    __syncthreads();
    LAS bf16_t* XI = (LAS bf16_t*)(L + PL_KK);
#define AINVT_OF(dd) (XI + (dd) * 3840)
#define BINVR_OF(dd) (XI + (dd) * 3840 + 1280)
#define CR_OF(dd) (XI + (dd) * 3840 + 2560)
    if (wid < 4) {
        const int dd = __builtin_amdgcn_readfirstlane(wid) >> 1, blk = __builtin_amdgcn_readfirstlane(wid) & 1, o = blk * 32;
        const LAS float* vgc = VGC_OF(dd); const LAS float* vbeta = vgc + 64;
        LAS bf16_t* TB = TB_OF(dd); LAS bf16_t* TBG = TBG_OF(dd);
        unsigned lcb = (unsigned)(size_t)(LC_OF(dd) + o * 64 + o); asm volatile("" : "+v"(lcb));
        const LAS float* Lcv = (const LAS float*)lcb;
        typedef float f32x2 __attribute__((ext_vector_type(2)));
        const int c = lane & 31, hh = lane >> 5;
        f32x2 x2[16];
#pragma unroll
        for (int m = 0; m < 16; ++m) x2[m] = (f32x2){(2 * m == c) ? 1.f : 0.f, (2 * m + 1 == c) ? 1.f : 0.f};
        float xprev = 0.f;
#pragma unroll
        for (int j = 0; j < 31; ++j) {
            const float xj = (j & 1) ? x2[j >> 1].y : x2[j >> 1].x; const f32x2 xjj = (f32x2){xj, xj};
            unsigned bj = lcb; asm volatile("" : "+v"(bj) : "v"(j ? xprev : xj)); const LAS float* Lj = (const LAS float*)bj; (void)Lcv;
            xprev = xj;
#pragma unroll
            for (int i4 = ((j + 1) & ~3); i4 < 32; i4 += 4) {
                const f32x4 l = *(const LAS f32x4*)(Lj + j * 64 + i4);
                x2[i4 >> 1] -= (f32x2){l.x, l.y} * xjj; x2[(i4 >> 1) + 1] -= (f32x2){l.z, l.w} * xjj;
            }
        }
        const int cdir = o + c, tc = dd ? 63 - cdir : cdir;
        const float bc = vbeta[cdir], bg = bc * __expf(vgc[cdir]);
        if (hh == 0) {
#pragma unroll
            for (int m = 0; m < 16; ++m) {
                TB[(o + 2 * m) * 72 + tc] = (bf16_t)f2bf(x2[m].x * bc); TBG[(o + 2 * m) * 72 + tc] = (bf16_t)f2bf(x2[m].x * bg);
                TB[(o + 2 * m + 1) * 72 + tc] = (bf16_t)f2bf(x2[m].y * bc); TBG[(o + 2 * m + 1) * 72 + tc] = (bf16_t)f2bf(x2[m].y * bg);
            }
            if (blk == 0) {
                LAS bf16_t* ai = AINVT_OF(dd) + c * 40;
#pragma unroll
                for (int q = 0; q < 4; ++q) { u32x4 w; w.x = cvt_pk_bf16(x2[4 * q].x, x2[4 * q].y); w.y = cvt_pk_bf16(x2[4 * q + 1].x, x2[4 * q + 1].y); w.z = cvt_pk_bf16(x2[4 * q + 2].x, x2[4 * q + 2].y); w.w = cvt_pk_bf16(x2[4 * q + 3].x, x2[4 * q + 3].y); *(LAS u32x4*)(ai + 8 * q) = w; }
            } else {
                LAS bf16_t* bi = BINVR_OF(dd) + c;
#pragma unroll
                for (int m = 0; m < 16; ++m) { bi[(2 * m) * 40] = (bf16_t)f2bf(x2[m].x); bi[(2 * m + 1) * 40] = (bf16_t)f2bf(x2[m].y); }
            }
        } else if (blk == 0) {
            const int cz = 32 + c, tz = dd ? 63 - cz : cz;
#pragma unroll
            for (int i = 0; i < 32; ++i) { TB[i * 72 + tz] = (bf16_t)0; TBG[i * 72 + tz] = (bf16_t)0; }
        }
    } else {
        const int t2 = tid - 256;
#pragma unroll
        for (int dd = 0; dd < 2; ++dd) {
            const LAS float* Lc = LC_OF(dd); LAS bf16_t* cr = CR_OF(dd);
#pragma unroll
            for (int e = 0; e < 4; ++e) { const int idx = t2 + 256 * e, k = idx >> 5, i = idx & 31; cr[i * 40 + k] = (bf16_t)f2bf(Lc[k * 64 + 32 + i]); }
        }
#pragma unroll
        for (int dd = 0; dd < 2; ++dd) {
            const LAS float* vgc = VGC_OF(dd); const float gl = vgc[63];
            unsigned char* item = p.ws + OFF_PREP + SLOT_OF(dd) * PREP_STRIDE;
            if (is_lat) {
                unsigned* oqk = (unsigned*)(item + PI_QK);
                for (int idx = t2; idx < 2048; idx += 256) {
                    const int i = idx >> 5, j0 = (idx & 31) * 2, ti = dd ? 63 - i : i;
                    const int tj0 = dd ? 63 - j0 : j0, tj1 = dd ? 62 - j0 : j0 + 1;
                    const float v0 = (i >= j0) ? QKf[ti * 65 + tj0] * __expf(vgc[i] - vgc[j0]) : 0.f;
                    const float v1 = (i >= j0 + 1) ? QKf[ti * 65 + tj1] * __expf(vgc[i] - vgc[j0 + 1]) : 0.f;
                    oqk[idx] = cvt_pk_bf16(v0, v1);
                }
                u32x4* oqd = (u32x4*)(item + PI_QD);
                for (int idx = t2; idx < 1024; idx += 256) {
                    const int i = idx >> 4, c8 = idx & 15, ti = dd ? 63 - i : i; const float eg = __expf(vgc[i]);
                    const u32x4 q = *(const LAS u32x4*)(Qn + ti * 136 + c8 * 8); u32x4 o;
                    o.x = cvt_pk_bf16(bflo(q.x) * eg, bfhi(q.x) * eg); o.y = cvt_pk_bf16(bflo(q.y) * eg, bfhi(q.y) * eg);
                    o.z = cvt_pk_bf16(bflo(q.z) * eg, bfhi(q.z) * eg); o.w = cvt_pk_bf16(bflo(q.w) * eg, bfhi(q.w) * eg);
                    oqd[idx] = o;
                }
            }
            u32x4* okd = (u32x4*)(item + PI_KDT);
            for (int idx = t2; idx < 1024; idx += 256) {
                const int dk = idx >> 3, j8 = idx & 7, tmin = dd ? 56 - j8 * 8 : j8 * 8;
                const u32x4 kq = *(const LAS u32x4*)(KT + dk * 72 + tmin);
                float e[8] = {bflo(kq.x), bfhi(kq.x), bflo(kq.y), bfhi(kq.y), bflo(kq.z), bfhi(kq.z), bflo(kq.w), bfhi(kq.w)};
                float r[8];
#pragma unroll
                for (int jj = 0; jj < 8; ++jj) r[jj] = (dd ? e[7 - jj] : e[jj]) * __expf(gl - vgc[j8 * 8 + jj]);
                u32x4 o; o.x = cvt_pk_bf16(r[0], r[1]); o.y = cvt_pk_bf16(r[2], r[3]); o.z = cvt_pk_bf16(r[4], r[5]); o.w = cvt_pk_bf16(r[6], r[7]);
                okd[idx] = o;
            }
            if (t2 == 0) *(float*)(item + PI_GL) = __expf(gl);
        }
    }
    __syncthreads();
    if (wid == 0 || wid == 2) {
        typedef float f32x16 __attribute__((ext_vector_type(16)));
        const int dd = __builtin_amdgcn_readfirstlane(wid) >> 1, r = lane & 31, hh = lane >> 5;
        const LAS float* vgc = VGC_OF(dd); const LAS float* vbeta = vgc + 64;
        LAS bf16_t* TB = TB_OF(dd); LAS bf16_t* TBG = TBG_OF(dd);
        f32x16 Y, M;
#pragma unroll
        for (int x = 0; x < 16; ++x) { Y[x] = 0.f; M[x] = 0.f; }
#pragma unroll
        for (int sx = 0; sx < 2; ++sx)
            Y = __builtin_amdgcn_mfma_f32_32x32x16_bf16(*(const LAS bf16x8*)(CR_OF(dd) + r * 40 + 16 * sx + 8 * hh), *(const LAS bf16x8*)(AINVT_OF(dd) + r * 40 + 16 * sx + 8 * hh), Y, 0, 0, 0);
#pragma unroll
        for (int sx = 0; sx < 2; ++sx) {
            u32x4 yb; yb.x = cvt_pk_bf16(Y[8 * sx], Y[8 * sx + 1]); yb.y = cvt_pk_bf16(Y[8 * sx + 2], Y[8 * sx + 3]); yb.z = cvt_pk_bf16(Y[8 * sx + 4], Y[8 * sx + 5]); yb.w = cvt_pk_bf16(Y[8 * sx + 6], Y[8 * sx + 7]);
            const u32x2 lo = *(const LAS u32x2*)(BINVR_OF(dd) + r * 40 + 16 * sx + 4 * hh), hi = *(const LAS u32x2*)(BINVR_OF(dd) + r * 40 + 16 * sx + 8 + 4 * hh);
            u32x4 pa; pa.x = lo.x; pa.y = lo.y; pa.z = hi.x; pa.w = hi.y;
            M = __builtin_amdgcn_mfma_f32_32x32x16_bf16(__builtin_bit_cast(bf16x8, pa), __builtin_bit_cast(bf16x8, yb), M, 0, 0, 0);
        }
        const int tc = dd ? 63 - r : r; const float bc = vbeta[r], bg = bc * __expf(vgc[r]);
#pragma unroll
        for (int x = 0; x < 16; ++x) {
            const int i = 32 + (x & 3) + 8 * (x >> 2) + 4 * hh;
            TB[i * 72 + tc] = (bf16_t)f2bf(-M[x] * bc); TBG[i * 72 + tc] = (bf16_t)f2bf(-M[x] * bg);
        }
    }
    __syncthreads();
#undef AINVT_OF
#undef BINVR_OF
#undef CR_OF
    {
        const int dd = __builtin_amdgcn_readfirstlane(wid) >> 2, mat = (wid >> 1) & 1;
        const LAS bf16_t* Am = mat ? TBG_OF(dd) : TB_OF(dd); const LAS bf16_t* Bm = mat ? KT : VT;
        LAS bf16_t* img = (LAS bf16_t*)(L + (dd ? PL_KK : PL_QN) + mat * 17408); const float sgn = mat ? -1.f : 1.f;
#pragma unroll
        for (int th = 0; th < 2; ++th) {
            const int ti = (wid & 1) * 2 + th;
            const bf16x8 a0 = *(const LAS bf16x8*)(Am + (ti * 16 + fr) * 72 + fq * 8), a1 = *(const LAS bf16x8*)(Am + (ti * 16 + fr) * 72 + 32 + fq * 8);
#pragma unroll
            for (int tn = 0; tn < 8; ++tn) {
                f32x4 acc = (f32x4){0.f, 0.f, 0.f, 0.f};
                acc = MFMA16(a0, *(const LAS bf16x8*)(Bm + (tn * 16 + fr) * 72 + fq * 8), acc);
                acc = MFMA16(a1, *(const LAS bf16x8*)(Bm + (tn * 16 + fr) * 72 + 32 + fq * 8), acc);
#pragma unroll
                for (int j = 0; j < 4; ++j) img[(ti * 16 + fq * 4 + j) * 136 + tn * 16 + fr] = (bf16_t)f2bf(acc[j] * sgn);
            }
        }
    }
    __syncthreads();
#pragma unroll
    for (int e = 0; e < 8; ++e) {
        const int idx = tid + NT * e, dd = idx >> 11, mat = (idx >> 10) & 1, row = (idx >> 4) & 63, cq = idx & 15;
        const u32x4 v = *(const LAS u32x4*)((const LAS bf16_t*)(L + (dd ? PL_KK : PL_QN) + mat * 17408) + row * 136 + cq * 8);
        *(u32x4*)(p.ws + OFF_PREP + SLOT_OF(dd) * PREP_STRIDE + (mat ? PI_W : PI_U) + row * 256 + cq * 16) = v;
    }
    __syncthreads();
#undef SLOT_OF
#undef LC_OF
#undef TB_OF
#undef TBG_OF
#undef VGC_OF
}

DI void chunk_mlp_item(const Params& p, LAS unsigned char* L, int b, int n, int g) {
    int tid_ = threadIdx.x; asm volatile("" : "+v"(tid_));
    const int tid = tid_, lane = tid & 63, wid = tid >> 6, fr = lane & 15, fq = lane >> 4;
    LAS bf16_t* SW = (LAS bf16_t*)L; LAS bf16_t* VNT = (LAS bf16_t*)(L + 34816);
    const int row0 = b * 2048 + n * 128;
    {
        const int pr = tid >> 2, part = tid & 3;
        const float* sw = p.spatial_w + ((size_t)g * 128 + pr) * 128 + part * 32;
#pragma unroll
        for (int i = 0; i < 4; ++i) {
            const f32x4 a = *(const f32x4*)(sw + i * 8), c = *(const f32x4*)(sw + i * 8 + 4);
            u32x4 w; w.x = cvt_pk_bf16(a.x, a.y); w.y = cvt_pk_bf16(a.z, a.w); w.z = cvt_pk_bf16(c.x, c.y); w.w = cvt_pk_bf16(c.z, c.w);
            *(LAS u32x4*)(SW + pr * 136 + part * 32 + i * 8) = w;
        }
        const bf16_t* zv = (const bf16_t*)(p.ws + OFF_ZV) + (size_t)(row0 + pr) * 1024 + g * 128 + part * 32;
        float v[32]; float ss = 0.f;
#pragma unroll
        for (int i = 0; i < 4; ++i) {
            const u32x4 q = *(const u32x4*)(zv + i * 8);
            v[i * 8 + 0] = bflo(q.x); v[i * 8 + 1] = bfhi(q.x); v[i * 8 + 2] = bflo(q.y); v[i * 8 + 3] = bfhi(q.y);
            v[i * 8 + 4] = bflo(q.z); v[i * 8 + 5] = bfhi(q.z); v[i * 8 + 6] = bflo(q.w); v[i * 8 + 7] = bfhi(q.w);
        }
#pragma unroll
        for (int i = 0; i < 32; ++i) ss += v[i] * v[i];
        ss += __shfl_xor(ss, 1); ss += __shfl_xor(ss, 2);
        const float rstd = rsqrtf(ss * (1.0f / 128.0f) + 1e-6f);
        const float* vg = p.mlp_norm_g + g * 128 + part * 32;
#pragma unroll
        for (int i = 0; i < 32; ++i) VNT[(part * 32 + i) * 136 + pr] = (bf16_t)f2bf(v[i] * rstd * vg[i]);
    }
    __syncthreads();
    f32x4 acc[8];
#pragma unroll
    for (int ci = 0; ci < 8; ++ci) acc[ci] = (f32x4){0.f, 0.f, 0.f, 0.f};
#pragma unroll
    for (int k = 0; k < 4; ++k) {
        const bf16x8 a = *(const LAS bf16x8*)(SW + (wid * 16 + fr) * 136 + k * 32 + fq * 8);
#pragma unroll
        for (int ci = 0; ci < 8; ++ci) acc[ci] = MFMA16(a, *(const LAS bf16x8*)(VNT + (ci * 16 + fr) * 136 + k * 32 + fq * 8), acc[ci]);
    }
    LAS float* Sf = (LAS float*)(L + 69632);
#pragma unroll
    for (int j = 0; j < 4; ++j) {
        const int pp = wid * 16 + fq * 4 + j; const float bs = p.spatial_b[g * 128 + pp];
#pragma unroll
        for (int ci = 0; ci < 8; ++ci) Sf[pp * 132 + ci * 16 + fr] = acc[ci][j] + bs;
    }
    __syncthreads();
    const bf16_t* ZU = (const bf16_t*)(p.ws + OFF_ZU); bf16_t* O = (bf16_t*)(p.ws + OFF_O);
#pragma unroll
    for (int e = 0; e < 4; ++e) {
        const int idx = tid + NT * e, pp = idx >> 4, c8 = idx & 15; const size_t row = row0 + pp;
        const u32x4 zu = *(const u32x4*)(ZU + row * 1024 + g * 128 + c8 * 8);
        const f32x4 s0 = *(const LAS f32x4*)(Sf + pp * 132 + c8 * 8), s1 = *(const LAS f32x4*)(Sf + pp * 132 + c8 * 8 + 4);
        u32x4 o; o.x = cvt_pk_bf16(bflo(zu.x) * s0.x, bfhi(zu.x) * s0.y); o.y = cvt_pk_bf16(bflo(zu.y) * s0.z, bfhi(zu.y) * s0.w);
        o.z = cvt_pk_bf16(bflo(zu.z) * s1.x, bfhi(zu.z) * s1.y); o.w = cvt_pk_bf16(bflo(zu.w) * s1.z, bfhi(zu.w) * s1.w);
        *(u32x4*)(O + row * D + 1024 + g * 128 + c8 * 8) = o;
    }
    __syncthreads();
}

constexpr int SL_W = 0, SL_QD = 17408, SL_KDT = 34816, SL_QK = 53248, SL_ST = 62464, SL_VN = 71168;
DI void dn_scan(const Params& p, LAS unsigned char* L, int ch, int round) {
    int tid_ = threadIdx.x; asm volatile("" : "+v"(tid_));
    const int tid = tid_, lane = tid & 63, wid = tid >> 6, fr = lane & 15, fq = lane >> 4;
    const int eq = ch & 3, d = (ch >> 2) & 1, h = (ch >> 3) & 7, bl = ch >> 6, b = round * 4 + bl;
    LAS bf16_t* Wl = (LAS bf16_t*)(L + SL_W); LAS bf16_t* QDl = (LAS bf16_t*)(L + SL_QD); LAS bf16_t* KDTl = (LAS bf16_t*)(L + SL_KDT);
    LAS bf16_t* QKl = (LAS bf16_t*)(L + SL_QK); LAS bf16_t* STl = (LAS bf16_t*)(L + SL_ST); LAS bf16_t* VNl = (LAS bf16_t*)(L + SL_VN);
    f32x4 S[2];
#pragma unroll
    for (int n2 = 0; n2 < 2; ++n2) S[n2] = (f32x4){0.f, 0.f, 0.f, 0.f};
    const int mi = wid >> 1, ni = wid & 1;
    const unsigned char* item0 = p.ws + OFF_PREP + (size_t)((((bl * 8 + h) * 2 + d) * 36)) * PREP_STRIDE;
    u32x4 rW[2][2], rQD[2][2], rKD[2][2], rQK[2]; bf16_t nU[4]; float nGL;
    int vz = 0; asm volatile("" : "+v"(vz));
#define SCAN_LOAD(P, it) do { const unsigned char* _p = (it); \
        rW[P][0] = *(const u32x4*)(_p + PI_W + tid * 16); rW[P][1] = *(const u32x4*)(_p + PI_W + (tid + NT) * 16); \
        rQD[P][0] = *(const u32x4*)(_p + PI_QD + tid * 16); rQD[P][1] = *(const u32x4*)(_p + PI_QD + (tid + NT) * 16); \
        rKD[P][0] = *(const u32x4*)(_p + PI_KDT + tid * 16); rKD[P][1] = *(const u32x4*)(_p + PI_KDT + (tid + NT) * 16); \
        rQK[P] = *(const u32x4*)(_p + PI_QK + tid * 16); } while (0)
#define SCAN_LOADU(it) do { const unsigned char* _p = (it); nGL = *(const float*)(_p + PI_GL + vz); \
        _Pragma("unroll") for (int _j = 0; _j < 4; ++_j) \
            nU[_j] = ((const bf16_t*)(_p + PI_U))[(mi * 16 + fq * 4 + _j) * 128 + eq * 32 + ni * 16 + fr]; } while (0)
#define SCAN_STORE_A(P) do { \
        _Pragma("unroll") for (int _i = 0; _i < 2; ++_i) { const int _x = tid + _i * NT; \
            *(LAS u32x4*)(Wl + (_x >> 4) * 136 + (_x & 15) * 8) = rW[P][_i]; *(LAS u32x4*)(QDl + (_x >> 4) * 136 + (_x & 15) * 8) = rQD[P][_i]; } } while (0)
#define SCAN_STORE_B(P) do { \
        _Pragma("unroll") for (int _i = 0; _i < 2; ++_i) { const int _x = tid + _i * NT; \
            *(LAS u32x4*)(KDTl + (_x >> 3) * 72 + (_x & 7) * 8) = rKD[P][_i]; } \
        *(LAS u32x4*)(QKl + (tid >> 3) * 72 + (tid & 7) * 8) = rQK[P]; } while (0)
    SCAN_LOADU(item0);
    SCAN_LOAD(0, item0);
    SCAN_LOAD(1, item0 + PREP_STRIDE);
#pragma unroll
    for (int n2 = 0; n2 < 2; ++n2) { u32x2 w; w.x = cvt_pk_bf16(S[n2][0], S[n2][1]); w.y = cvt_pk_bf16(S[n2][2], S[n2][3]); *(LAS u32x2*)(STl + (n2 * 16 + fr) * 136 + wid * 16 + fq * 4) = w; }
    SCAN_STORE_A(0); SCAN_STORE_B(0);
    __syncthreads();
    for (int s2 = 0; s2 < NSTEP; s2 += 2) {
#pragma unroll
      for (int par = 0; par < 2; ++par) {
        const int s = s2 + par;
        f32x4 vacc = (f32x4){bf2f(nU[0]), bf2f(nU[1]), bf2f(nU[2]), bf2f(nU[3])}; const float gl = nGL;
        if (s + 1 < NSTEP) SCAN_LOADU(item0 + (size_t)(s + 1) * PREP_STRIDE);
        if (s + 2 < NSTEP) SCAN_LOAD(par, item0 + (size_t)(s + 2) * PREP_STRIDE);
        f32x4 oacc = (f32x4){0.f, 0.f, 0.f, 0.f};
#pragma unroll
        for (int k = 0; k < 4; ++k) {
            const bf16x8 sb = *(const LAS bf16x8*)(STl + (ni * 16 + fr) * 136 + k * 32 + fq * 8);
            vacc = MFMA16(*(const LAS bf16x8*)(Wl + (mi * 16 + fr) * 136 + k * 32 + fq * 8), sb, vacc);
            if (s >= 4) oacc = MFMA16(*(const LAS bf16x8*)(QDl + (mi * 16 + fr) * 136 + k * 32 + fq * 8), sb, oacc);
        }
        { u32x2 w; w.x = cvt_pk_bf16(vacc[0], vacc[1]); w.y = cvt_pk_bf16(vacc[2], vacc[3]); *(LAS u32x2*)(VNl + (ni * 16 + fr) * 72 + mi * 16 + fq * 4) = w; }
        __syncthreads();
        if (s >= 4) {
#pragma unroll
            for (int k = 0; k < 2; ++k)
                oacc = MFMA16(*(const LAS bf16x8*)(QKl + (mi * 16 + fr) * 72 + k * 32 + fq * 8), *(const LAS bf16x8*)(VNl + (ni * 16 + fr) * 72 + k * 32 + fq * 8), oacc);
            const int lc = d ? 31 - (s - 4) : (s - 4);
            bf16_t* od = (bf16_t*)(p.ws + OFF_ODIR) + (size_t)d * MX * 1024;
#pragma unroll
            for (int j = 0; j < 4; ++j) {
                const int i = mi * 16 + fq * 4 + j, tok = d ? 63 - i : i; const size_t row = (size_t)b * 2048 + lc * 64 + tok;
                od[row * 1024 + h * 128 + eq * 32 + ni * 16 + fr] = (bf16_t)f2bf(oacc[j]);
            }
        }
#pragma unroll
        for (int n2 = 0; n2 < 2; ++n2) S[n2] *= gl;
#pragma unroll
        for (int k = 0; k < 2; ++k) {
            const bf16x8 a = *(const LAS bf16x8*)(KDTl + (wid * 16 + fr) * 72 + k * 32 + fq * 8);
#pragma unroll
            for (int n2 = 0; n2 < 2; ++n2) S[n2] = MFMA16(a, *(const LAS bf16x8*)(VNl + (n2 * 16 + fr) * 72 + k * 32 + fq * 8), S[n2]);
        }
#pragma unroll
        for (int n2 = 0; n2 < 2; ++n2) { u32x2 w; w.x = cvt_pk_bf16(S[n2][0], S[n2][1]); w.y = cvt_pk_bf16(S[n2][2], S[n2][3]); *(LAS u32x2*)(STl + (n2 * 16 + fr) * 136 + wid * 16 + fq * 4) = w; }
        if (s + 1 < NSTEP) SCAN_STORE_A(par ^ 1);
        __syncthreads();
        if (s + 1 < NSTEP) SCAN_STORE_B(par ^ 1);
      }
    }
#undef SCAN_LOAD
#undef SCAN_LOADU
#undef SCAN_STORE_A
#undef SCAN_STORE_B
}

DI void combine_phase(const Params& p, int gw, int NGW, int lane) {
    const bf16_t* o0 = (const bf16_t*)(p.ws + OFF_ODIR); const bf16_t* o1 = o0 + (size_t)MX * 1024;
    const bf16_t* zg = (const bf16_t*)(p.ws + OFF_ZG); bf16_t* O = (bf16_t*)(p.ws + OFF_O);
    for (int r = gw; r < MX; r += NGW) {
        const size_t off = (size_t)r * 1024 + lane * 16;
        float v[16], gt[16]; float ss = 0.f;
#pragma unroll
        for (int i = 0; i < 2; ++i) {
            const u32x4 a = *(const u32x4*)(o0 + off + i * 8), c = *(const u32x4*)(o1 + off + i * 8), g = *(const u32x4*)(zg + off + i * 8);
            v[i * 8 + 0] = bflo(a.x) + bflo(c.x); v[i * 8 + 1] = bfhi(a.x) + bfhi(c.x); v[i * 8 + 2] = bflo(a.y) + bflo(c.y); v[i * 8 + 3] = bfhi(a.y) + bfhi(c.y);
            v[i * 8 + 4] = bflo(a.z) + bflo(c.z); v[i * 8 + 5] = bfhi(a.z) + bfhi(c.z); v[i * 8 + 6] = bflo(a.w) + bflo(c.w); v[i * 8 + 7] = bfhi(a.w) + bfhi(c.w);
            gt[i * 8 + 0] = bflo(g.x); gt[i * 8 + 1] = bfhi(g.x); gt[i * 8 + 2] = bflo(g.y); gt[i * 8 + 3] = bfhi(g.y);
            gt[i * 8 + 4] = bflo(g.z); gt[i * 8 + 5] = bfhi(g.z); gt[i * 8 + 6] = bflo(g.w); gt[i * 8 + 7] = bfhi(g.w);
        }
#pragma unroll
        for (int i = 0; i < 16; ++i) ss += v[i] * v[i];
        ss += __shfl_xor(ss, 1); ss += __shfl_xor(ss, 2); ss += __shfl_xor(ss, 4);
        const float rstd = rsqrtf(ss * (1.0f / 128.0f) + 1e-6f);
        const float* hg = p.head_norm_g + (lane & 7) * 16;
        float y[16];
#pragma unroll
        for (int i = 0; i < 16; ++i) y[i] = v[i] * rstd * hg[i] * gt[i];
        u32x4 w0, w1;
        w0.x = cvt_pk_bf16(y[0], y[1]); w0.y = cvt_pk_bf16(y[2], y[3]); w0.z = cvt_pk_bf16(y[4], y[5]); w0.w = cvt_pk_bf16(y[6], y[7]);
        w1.x = cvt_pk_bf16(y[8], y[9]); w1.y = cvt_pk_bf16(y[10], y[11]); w1.z = cvt_pk_bf16(y[12], y[13]); w1.w = cvt_pk_bf16(y[14], y[15]);
        bf16_t* op = O + (size_t)r * D + lane * 16;
        *(u32x4*)op = w0; *(u32x4*)(op + 8) = w1;
    }
}

#define XB_TMO      128
#define XB_XCNT(j)  (256  + 64 * (j))
#define XB_XSUB(j)  (1280 + 64 * (j))
#define XB_XGEN(j)  (2304 + 64 * (j))
#define XB_TOP      3328
#define XB_TOPGEN   3392
#define XCD_BAR_WORDS 3456
#define XB_SPIN_CAP (1u << 18)

__device__ __forceinline__ unsigned xb_ld(unsigned* p)              { return __hip_atomic_load(p, __ATOMIC_RELAXED, __HIP_MEMORY_SCOPE_AGENT); }
__device__ __forceinline__ unsigned xb_add(unsigned* p, unsigned v) { return __hip_atomic_fetch_add(p, v, __ATOMIC_RELAXED, __HIP_MEMORY_SCOPE_AGENT); }
__device__ __forceinline__ unsigned xb_xcc_id() { return (unsigned)__builtin_amdgcn_s_getreg((3 << 11) | 20) & 0xFu; }
#define XB_SPIN(cond, bar) do { unsigned _sp = 0; while (cond) { __builtin_amdgcn_s_sleep(1); \
    if ((++_sp & 255u) == 0u) { if (xb_ld(&(bar)[XB_TMO])) break; if (_sp > XB_SPIN_CAP) { atomicAdd(&(bar)[XB_TMO], 1u); break; } } } } while (0)

struct XcdBarrier {
    unsigned* bar; unsigned x;
    volatile LAS unsigned* st;
};

__device__ __forceinline__ XcdBarrier xcd_barrier_post(unsigned* bar, volatile LAS unsigned* st) {
    XcdBarrier b; b.bar = bar; b.x = xb_xcc_id(); b.st = st;
    if (threadIdx.x == 0) (void)xb_add(&bar[XB_XCNT(b.x)], 1u);
    return b;
}
__device__ __forceinline__ void xcd_barrier_complete(unsigned* bar, unsigned x, unsigned& nloc, unsigned& nx) {
    const unsigned G = gridDim.x * gridDim.y * gridDim.z;
    unsigned sum, cnt, mine, sp = 0u;
    for (;;) {
        sum = 0u; cnt = 0u; mine = 0u;
#pragma unroll
        for (unsigned j = 0; j < 16; ++j) { const unsigned c = xb_ld(&bar[XB_XCNT(j)]); sum += c; cnt += (c > 0u) ? 1u : 0u; mine = (j == x) ? c : mine; }
        if (sum == G) break;
        __builtin_amdgcn_s_sleep(1);
        if ((++sp & 255u) == 0u) { if (xb_ld(&bar[XB_TMO])) break; if (sp > XB_SPIN_CAP) { atomicAdd(&bar[XB_TMO], 1u); break; } }
    }
    nloc = mine > 0u ? mine : 1u; nx = cnt > 0u ? cnt : 1u;
}

__device__ __forceinline__ void xcd_barrier(const XcdBarrier& b) {
    asm volatile("s_waitcnt vmcnt(0)" ::: "memory");
    __syncthreads();
    if (threadIdx.x == 0) {
        unsigned* bar = b.bar;
        __builtin_amdgcn_s_waitcnt(0);
        unsigned nloc = b.st[0], nx = b.st[1];
        if (nloc == 0u) { xcd_barrier_complete(bar, b.x, nloc, nx); b.st[0] = nloc; b.st[1] = nx; }
        const unsigned old = xb_add(&bar[XB_XSUB(b.x)], 1u);
        const unsigned gen = old / nloc;
        if (old + 1u == (gen + 1u) * nloc) {
            __builtin_amdgcn_fence(__ATOMIC_RELEASE, "agent");
            asm volatile("s_waitcnt vmcnt(0)" ::: "memory");
            const unsigned og = xb_add(&bar[XB_TOP], 1u);
            const unsigned tg = og / nx;
            if (og + 1u == (tg + 1u) * nx) xb_add(&bar[XB_TOPGEN], 1u);
            else XB_SPIN(xb_ld(&bar[XB_TOPGEN]) == tg, bar);
            __builtin_amdgcn_fence(__ATOMIC_ACQUIRE, "agent");
            xb_add(&bar[XB_XGEN(b.x)], 1u);
            asm volatile("s_waitcnt vmcnt(0)" ::: "memory");
        } else {
            XB_SPIN(xb_ld(&bar[XB_XGEN(b.x)]) == gen, bar);
            __builtin_amdgcn_fence(__ATOMIC_ACQUIRE, "agent");
            asm volatile("s_waitcnt vmcnt(0)" ::: "memory");
        }
    }
    __syncthreads();
}

DI void fast_gsync(unsigned* bar, unsigned target) {
    asm volatile("s_waitcnt vmcnt(0)" ::: "memory");
    __syncthreads();
    if (threadIdx.x == 0) {
        __builtin_amdgcn_fence(__ATOMIC_RELEASE, "agent");
        asm volatile("s_waitcnt vmcnt(0)" ::: "memory");
        __hip_atomic_fetch_add(bar, 1u, __ATOMIC_RELAXED, __HIP_MEMORY_SCOPE_AGENT);
        while (__hip_atomic_load(bar, __ATOMIC_RELAXED, __HIP_MEMORY_SCOPE_AGENT) < target) __builtin_amdgcn_s_sleep(1);
        __builtin_amdgcn_fence(__ATOMIC_ACQUIRE, "agent");
        asm volatile("s_waitcnt vmcnt(0)" ::: "memory");
    }
    __syncthreads();
}
template <class Epi> DI void run_gemm(LAS unsigned char* L, const bf16_t* A, const bf16_t* Bt, int M, int N, int K, const Epi& E) {
    pg8::Gemm g{A, Bt, M, N, K}; pg8::StaticOrder S; S.init(M, N, (int)gridDim.x, (int)blockIdx.x);
    pg8::gemm_phase<Epi, pg8::StaticOrder, false>(L, g, S, E, nullptr);
    __syncthreads();
}

struct InprojOrder {
    int G, c;
    DI bool next(int i, Unit& u) const {
        const int Lx = i * G + c; if (Lx >= 1704) return false;
        if (Lx < 1600) { const int wgid = (Lx % 8) * 200 + Lx / 8; const int gid = wgid / 200, rem = wgid % 200; u.pm = gid * 8 + (rem % 8); u.pn = rem / 8; }
        else { const int l2 = Lx - 1600, q = l2 % 13; u.pm = 64 + l2 / 13; u.pn = q < 12 ? q : 24; }
        return true;
    }
    DI void a_ready(const Unit&) const {}
    DI void done(const Unit&) const {}
};
struct FfnUpOrder {
    int c;
    DI bool next(int i, Unit& u) const {
        const int xcd = c & 7, slot = c >> 3, j = i * 32 + slot;
        if (j >= 387) return false;
        if (j < 344) { u.pm = xcd * 8 + (j & 7); u.pn = j >> 3; }
        else { const int q = xcd * 43 + (j - 344); u.pm = 64 + (q & 7); u.pn = q >> 3; }
        return true;
    }
    DI void a_ready(const Unit&) const {}
    DI void done(const Unit&) const {}
};
__global__ void __launch_bounds__(NT, 2) fwd_megakernel(Params p_unused) {
    extern __shared__ __attribute__((aligned(16))) unsigned char lds_raw[];
    LAS unsigned char* L = (LAS unsigned char*)lds_raw;
    cg::grid_group grid = cg::this_grid();
#define GSYNC_CG() do { __builtin_amdgcn_fence(__ATOMIC_RELEASE, "agent"); grid.sync(); __builtin_amdgcn_fence(__ATOMIC_ACQUIRE, "agent"); } while (0)
    XcdBarrier xbar;
    { volatile LAS unsigned* st = (volatile LAS unsigned*)(L + 159488);
      if (threadIdx.x < 2) st[threadIdx.x] = 0u;
      __syncthreads();
      const Params pb_ = load_params();
      xbar = xcd_barrier_post((unsigned*)(pb_.ws + OFF_BAR), st); }
#define GSYNC() do { if (gridDim.x == 256) xcd_barrier(xbar); else GSYNC_CG(); } while (0)
#define TIDS const int tid = threadIdx.x, lane = tid & 63, wid = __builtin_amdgcn_readfirstlane(tid >> 6); const int G = gridDim.x, bid = blockIdx.x, gw = bid * 8 + wid, NGW = G * 8; (void)lane; (void)gw; (void)NGW; (void)G; (void)bid
    { TIDS; const Params p = load_params();
      mod_gemv(p, L, bid, G);
      if (G == 256) { if (bid >= 32) convert_weights(p.ffn1_w_in, D, NUP, NUP, 1, (bf16_t*)(p.ws + OFF_WT_FFN_IN), L, (bid - 32) * 8 + wid, 224 * 8, wid, lane); }
      else convert_weights(p.ffn1_w_in, D, NUP, NUP, 1, (bf16_t*)(p.ws + OFF_WT_FFN_IN), L, gw, NGW, wid, lane);
      if (G != 256) {
          convert_weights(p.ffn1_w_out, FF, D, D, 0, (bf16_t*)(p.ws + OFF_WT_FFN_OUT), L, gw, NGW, wid, lane);
          convert_weights(p.w_in, D, 6176, NIN, 2, (bf16_t*)(p.ws + OFF_WT_IN), L, gw, NGW, wid, lane);
          convert_weights(p.w_out, D, D, D, 0, (bf16_t*)(p.ws + OFF_WT_OUT), L, gw, NGW, wid, lane);
      } }
    GSYNC();
    { TIDS; const Params p = load_params();
      if (G == 256) {
          norm_mod_batched(p.x, p.norm_g, (const float*)(p.ws + OFF_MOD), 0, (bf16_t*)(p.ws + OFF_H), L, bid, 256, wid, lane);
          norm_mod_phase(p.x, p.ctx, MX, MALL, p.norm_g, (const float*)(p.ws + OFF_MOD), 0, (bf16_t*)(p.ws + OFF_H), gw, NGW, lane);
      } else norm_mod_phase(p.x, p.ctx, 0, MALL, p.norm_g, (const float*)(p.ws + OFF_MOD), 0, (bf16_t*)(p.ws + OFF_H), gw, NGW, lane); }
    GSYNC();
    { const Params p = load_params();
      if (gridDim.x == 256) {
          pg8::Gemm g{(const bf16_t*)(p.ws + OFF_H), (const bf16_t*)(p.ws + OFF_WT_FFN_IN), MALL, NUP, D}; const FfnUpOrder S{(int)blockIdx.x}; const EpiSwiglu E{(bf16_t*)(p.ws + OFF_G)};
          pg8::gemm_phase<EpiSwiglu, FfnUpOrder, false>(L, g, S, E, nullptr);
          __syncthreads();
      } else run_gemm(L, (const bf16_t*)(p.ws + OFF_H), (const bf16_t*)(p.ws + OFF_WT_FFN_IN), MALL, NUP, D, EpiSwiglu{(bf16_t*)(p.ws + OFF_G)});
      if (gridDim.x == 256 && blockIdx.x >= 24) { TIDS;
          convert_weights(p.ffn1_w_out, FF, D, D, 0, (bf16_t*)(p.ws + OFF_WT_FFN_OUT), L, (bid - 24) * 8 + wid, 232 * 8, wid, lane);
          convert_weights(p.w_in, D, 6176, NIN, 2, (bf16_t*)(p.ws + OFF_WT_IN), L, (bid - 24) * 8 + wid, 232 * 8, wid, lane);
          convert_weights(p.w_out, D, D, D, 0, (bf16_t*)(p.ws + OFF_WT_OUT), L, (bid - 24) * 8 + wid, 232 * 8, wid, lane); } }
    GSYNC();
    { const Params p = load_params();
      run_gemm(L, (const bf16_t*)(p.ws + OFF_G), (const bf16_t*)(p.ws + OFF_WT_FFN_OUT), MX, D, FF, EpiResid{p.x, p.ctx, p.out, (float*)(p.ws + OFF_CTX1), (const float*)(p.ws + OFF_MOD), 2, 0.5f, 0}); }
    GSYNC();
    { TIDS; const Params p = load_params();
      if (G == 256) {
          float* Pp = (float*)(p.ws + OFF_CTX1);
          if (bid < 128) {
              const int half = bid >> 6, koff = half ? 2816 : 0;
              pg8::Gemm g{(const bf16_t*)(p.ws + OFF_G) + (size_t)MX * FF + koff, (const bf16_t*)(p.ws + OFF_WT_FFN_OUT) + koff, MC, D, half ? 2688 : 2816, FF};
              pg8::StaticOrder S; S.init(MC, D, 64, bid & 63);
              const EpiPartial E{Pp + (size_t)half * MC * D};
              pg8::gemm_phase<EpiPartial, pg8::StaticOrder, false>(L, g, S, E, nullptr);
              __syncthreads();
              convert_weights(p.ffn2_w_in, D, NUP, NUP, 1, (bf16_t*)(p.ws + OFF_WT_FFN_IN), L, bid * 8 + wid, 128 * 8, wid, lane, 0, 2);
          } else {
              norm_mod_batched(p.out, p.norm_g + D, (const float*)(p.ws + OFF_MOD), 3, (bf16_t*)(p.ws + OFF_H), L, bid - 128, 128, wid, lane);
              convert_weights(p.ffn2_w_in, D, NUP, NUP, 1, (bf16_t*)(p.ws + OFF_WT_FFN_IN), L, (bid - 128) * 8 + wid, 128 * 8, wid, lane, 1, 2);
          }
      } else if (G >= 128) {
          if (bid < 64) {
              pg8::Gemm g{(const bf16_t*)(p.ws + OFF_G) + (size_t)MX * FF, (const bf16_t*)(p.ws + OFF_WT_FFN_OUT), MC, D, FF}; pg8::StaticOrder S; S.init(MC, D, 64, bid);
              const EpiResid E{p.ctx, p.ctx, (float*)(p.ws + OFF_CTX1), (float*)(p.ws + OFF_CTX1), (const float*)(p.ws + OFF_MOD), 2, 0.5f, 1};
              pg8::gemm_phase<EpiResid, pg8::StaticOrder, false>(L, g, S, E, nullptr);
              __syncthreads();
          } else {
              const int gw2 = (bid - 64) * 8 + wid, NGW2 = (G - 64) * 8;
              if (G == 256) norm_mod_batched(p.out, p.norm_g + D, (const float*)(p.ws + OFF_MOD), 3, (bf16_t*)(p.ws + OFF_H), L, bid - 64, 192, wid, lane);
              else norm_mod_phase(p.out, p.out, 0, MX, p.norm_g + D, (const float*)(p.ws + OFF_MOD), 3, (bf16_t*)(p.ws + OFF_H), gw2, NGW2, lane);
              convert_weights(p.ffn2_w_in, D, NUP, NUP, 1, (bf16_t*)(p.ws + OFF_WT_FFN_IN), L, gw2, NGW2, wid, lane);
          }
      } else {
          run_gemm(L, (const bf16_t*)(p.ws + OFF_G) + (size_t)MX * FF, (const bf16_t*)(p.ws + OFF_WT_FFN_OUT), MC, D, FF, EpiResid{p.ctx, p.ctx, (float*)(p.ws + OFF_CTX1), (float*)(p.ws + OFF_CTX1), (const float*)(p.ws + OFF_MOD), 2, 0.5f, 1});
          norm_mod_phase(p.out, p.out, 0, MX, p.norm_g + D, (const float*)(p.ws + OFF_MOD), 3, (bf16_t*)(p.ws + OFF_H), gw, NGW, lane);
          convert_weights(p.ffn2_w_in, D, NUP, NUP, 1, (bf16_t*)(p.ws + OFF_WT_FFN_IN), L, gw, NGW, wid, lane);
      } }
    GSYNC();
    { TIDS; const Params p = load_params();
      if (G == 256) ctx_norm_from_partials(p.ctx, (const float*)(p.ws + OFF_CTX1), (const float*)(p.ws + OFF_CTX1) + (size_t)MC * D, p.norm_g + D, (const float*)(p.ws + OFF_MOD), (bf16_t*)(p.ws + OFF_H), gw, NGW, lane);
      else norm_mod_phase(p.out, (const float*)(p.ws + OFF_CTX1), MX, MALL, p.norm_g + D, (const float*)(p.ws + OFF_MOD), 3, (bf16_t*)(p.ws + OFF_H), gw, NGW, lane);
      if (G != 256) convert_weights(p.ffn2_w_out, FF, D, D, 0, (bf16_t*)(p.ws + OFF_WT_FFN_OUT), L, gw, NGW, wid, lane); }
    GSYNC();
    { const Params p = load_params();
      pg8::Gemm g{(const bf16_t*)(p.ws + OFF_H), (const bf16_t*)(p.ws + OFF_WT_IN), MALL, NIN, D}; const InprojOrder S{(int)gridDim.x, (int)blockIdx.x};
      const EpiInproj E{p.ws};
      pg8::gemm_phase<EpiInproj, InprojOrder, false>(L, g, S, E, nullptr);
      __syncthreads();
      if (gridDim.x == 256 && blockIdx.x >= 168) { TIDS; convert_weights(p.ffn2_w_out, FF, D, D, 0, (bf16_t*)(p.ws + OFF_WT_FFN_OUT), L, (bid - 168) * 8 + wid, 88 * 8, wid, lane); } }
    GSYNC();
    for (int round = 0; round < NROUND; ++round) {
        { const Params p = load_params(); const int G = gridDim.x, bid = blockIdx.x;
          if (G == 256) {
              { const int xq = bid & 7, yq = bid >> 3;
                for (int k = yq; k < 144; k += 32) dn_prep_item(p, L, round * 4 + (xq >> 1), k >> 2, (xq & 1) * 4 + (k & 3)); }
              if (bid < 128) { const int m = round * 128 + bid; chunk_mlp_item(p, L, m >> 7, (m >> 3) & 15, m & 7); }
              else { for (int q = 0; q < 3; ++q) { const int m = 256 + (round * 3 + q) * 128 + (bid - 128); chunk_mlp_item(p, L, m >> 7, (m >> 3) & 15, m & 7); } }
          } else {
              const int nitems = 1152 + (round == 0 ? 1024 : 0);
              for (int it = bid; it < nitems; it += G) {
                  if (it < 1152) { dn_prep_item(p, L, round * 4 + it / 288, (it >> 3) % 36, it & 7); }
                  else { const int m = it - 1152; chunk_mlp_item(p, L, m >> 7, (m >> 3) & 15, m & 7); }
              }
          } }
        GSYNC();
        { const Params p = load_params(); const int G = gridDim.x, bid = blockIdx.x;
          for (int c0 = bid; c0 < 256; c0 += G) { const int xq = c0 & 7, yq = c0 >> 3, ch = ((xq * 8 + (yq >> 2)) << 2) | (yq & 3); dn_scan(p, L, ch, round); __syncthreads(); } }
        GSYNC();
    }
    { TIDS; const Params p = load_params(); combine_phase(p, gw, NGW, lane); }
    GSYNC();
    { const Params p = load_params();
      run_gemm(L, (const bf16_t*)(p.ws + OFF_O), (const bf16_t*)(p.ws + OFF_WT_OUT), MX, D, D, EpiResid{p.out, p.out, p.out, p.out, (const float*)(p.ws + OFF_MOD), 5, 1.0f, 0}); }
    GSYNC();
    { TIDS; const Params p = load_params();
      if (G == 256) norm_mod_batched(p.out, p.norm_g + 2 * D, (const float*)(p.ws + OFF_MOD), 6, (bf16_t*)(p.ws + OFF_H), L, bid, 256, wid, lane);
      else norm_mod_phase(p.out, p.out, 0, MX, p.norm_g + 2 * D, (const float*)(p.ws + OFF_MOD), 6, (bf16_t*)(p.ws + OFF_H), gw, NGW, lane); }
    GSYNC();
    { const Params p = load_params();
      run_gemm(L, (const bf16_t*)(p.ws + OFF_H), (const bf16_t*)(p.ws + OFF_WT_FFN_IN), MX, NUP, D, EpiSwiglu{(bf16_t*)(p.ws + OFF_G)}); }
    GSYNC();
    { const Params p = load_params();
      run_gemm(L, (const bf16_t*)(p.ws + OFF_G), (const bf16_t*)(p.ws + OFF_WT_FFN_OUT), MX, D, FF, EpiResid{p.out, p.out, p.out, p.out, (const float*)(p.ws + OFF_MOD), 8, 0.5f, 0}); }
    GSYNC();
    { TIDS; const Params p = load_params(); final_norm_phase(p.out, p.final_g, gw, NGW, lane); }
}

extern "C" void kernel_launch(void* const* d_in, const int* in_sizes, int n_in, void* d_out, int out_size, void* d_ws, size_t ws_size, hipStream_t stream) {
    static int grid_blocks = 0;
    if (grid_blocks == 0) {
        if (n_in != 21 || ws_size < WS_END) { fprintf(stderr, "kernel_launch: unexpected n_in %d or ws_size %zu < %zu\n", n_in, ws_size, (size_t)WS_END); grid_blocks = -1; return; }
        int dev = 0, cus = 0, per_cu = 0;
        hipGetDevice(&dev);
        hipDeviceGetAttribute(&cus, hipDeviceAttributeMultiprocessorCount, dev);
        hipFuncSetAttribute((const void*)fwd_megakernel, hipFuncAttributeMaxDynamicSharedMemorySize, LDS_BYTES);
        hipOccupancyMaxActiveBlocksPerMultiprocessor(&per_cu, (const void*)fwd_megakernel, NT, LDS_BYTES);
        if (per_cu < 1) per_cu = 1;
        grid_blocks = cus * per_cu;
        (void)hipGetLastError();
    }
    if (grid_blocks < 0) return;
    Params p{};
    const float** pp = (const float**)&p;
    for (int i = 0; i < 21; ++i) pp[i] = (const float*)d_in[i];
    p.out = (float*)d_out; p.ws = (unsigned char*)d_ws;
    hipMemsetAsync((unsigned char*)d_ws + OFF_BAR, 0, 16384, stream);
    void* args[] = {&p};
    hipError_t e = hipLaunchCooperativeKernel((const void*)fwd_megakernel, dim3(grid_blocks), dim3(NT), args, LDS_BYTES, stream);
    if (e != hipSuccess) fprintf(stderr, "cooperative launch failed: %s (grid %d)\n", hipGetErrorString(e), grid_blocks);
}
```
